# Optimizing an MI355X kernel written in HIP

```python
import jax, jax.numpy as jnp
from jax import lax
import numpy as np

D_MODEL = 1024
BATCH = 4
SEQ = 8192
DEPTH = 2

D_FF = 2816
HG_DK = 128
HG_HEADS = D_MODEL // HG_DK
HG_DV = D_MODEL // HG_HEADS
HG_WK = HG_HEADS * HG_DK
HG_WV = HG_HEADS * HG_DV
HG_CHUNK = 64
ATT_PATTERNS = ((128, 1), (512, 4), (2048, 16))
ATT_GROUPS = 3
ATT_HEADS = 4
ATT_DH = 128
ATT_W = ATT_GROUPS * ATT_HEADS * ATT_DH
ATT_OUT = ATT_HEADS * ATT_DH
ROPE_THETA = 10000.0
EPS = 1e-6
SPLIT_SIZES = (HG_WK, HG_WK, HG_WV, HG_WV, ATT_W, ATT_W, ATT_W, D_MODEL, D_MODEL)
P_IN = sum(SPLIT_SIZES)

kernel_name = "hybrid_hgrn2_dilated_attn_macaron"


def rms(x):
    xf = x.astype(jnp.float32)
    return xf * lax.rsqrt(jnp.mean(xf * xf, axis=-1, keepdims=True) + EPS)


def rmsnorm(x, g):
    return (rms(x) * g.astype(jnp.float32)).astype(x.dtype)


def swiglu(h, w_in, w_out):
    a, b = jnp.split(h @ w_in, 2, axis=-1)
    return (jax.nn.silu(a) * b) @ w_out


def rope_tables(t):
    pos = jnp.arange(t, dtype=jnp.float32)
    inv = ROPE_THETA ** (-jnp.arange(0, ATT_DH, 2, dtype=jnp.float32) / ATT_DH)
    ang = pos[:, None] * inv[None, :]
    ang = jnp.concatenate([ang, ang], axis=-1)
    return jnp.cos(ang), jnp.sin(ang)


def apply_rope(x, cos, sin):
    x1, x2 = jnp.split(x, 2, axis=-1)
    return x * cos + jnp.concatenate([-x2, x1], axis=-1) * sin


def hgrn2_chunk_scan(q, k, v, log_f):
    b, t, h, dk = q.shape
    dv = v.shape[-1]
    n = t // HG_CHUNK

    def chunks(a):
        return a.reshape(b, n, HG_CHUNK, h, a.shape[-1]).transpose(1, 0, 3, 2, 4)

    causal = jnp.tril(jnp.ones((HG_CHUNK, HG_CHUNK), dtype=bool))[:, :, None]

    def step(state, inp):
        qc, kc, vc, gc = inp
        gcum = jnp.cumsum(gc, axis=2)
        diff = gcum[:, :, :, None, :] - gcum[:, :, None, :, :]
        decay = jnp.exp(jnp.where(causal, diff, -jnp.inf))
        attn = jnp.einsum('bhtk,bhsk,bhtsk->bhts', qc, kc, decay)
        o = jnp.einsum('bhts,bhsv->bhtv', attn, vc) + jnp.einsum(
            'bhtk,bhkv->bhtv', qc * jnp.exp(gcum), state)
        g_last = gcum[:, :, -1:, :]
        state = jnp.exp(g_last[:, :, 0, :, None]) * state + jnp.einsum(
            'bhsk,bhsv->bhkv', kc * jnp.exp(g_last - gcum), vc)
        return state, o

    s0 = jnp.zeros((b, h, dk, dv), jnp.float32)
    _, o = lax.scan(step, s0, (chunks(q), chunks(k), chunks(v), chunks(log_f)))
    return o.transpose(1, 0, 3, 2, 4).reshape(b, t, h * dv)


def dilated_window_attention(q, k, v, window, dilation):
    b, h, t, dh = q.shape
    back = window // dilation
    blk = back
    L = t // dilation
    nb = -(-L // blk)
    Lp = nb * blk

    def to_res(a):
        a = a.reshape(b, h, L, dilation, dh).transpose(0, 1, 3, 2, 4)
        return jnp.pad(a, ((0, 0), (0, 0), (0, 0), (0, Lp - L), (0, 0)))

    def kv_blocks(a):
        a = jnp.pad(a, ((0, 0), (0, 0), (0, 0), (blk, 0), (0, 0)))
        a = a.reshape(b, h, dilation, nb + 1, blk, dh)
        return jnp.concatenate([a[:, :, :, :-1], a[:, :, :, 1:]], axis=4)

    qb = to_res(q).reshape(b, h, dilation, nb, blk, dh)
    kb = kv_blocks(to_res(k))
    vb = kv_blocks(to_res(v))
    s = jnp.einsum('bhrnqd,bhrnkd->bhrnqk', qb, kb) * (dh ** -0.5)
    qi = jnp.arange(blk)[:, None]
    ki = jnp.arange(2 * blk)[None, :]
    band = (ki >= qi) & (ki <= qi + back)
    valid = (ki >= blk)[None] | (jnp.arange(nb)[:, None, None] > 0)
    mask = band[None] & valid
    s = jnp.where(mask, s, -jnp.inf)
    lse = jax.nn.logsumexp(s, axis=-1)
    p = jnp.exp(s - lse[..., None])
    o = jnp.einsum('bhrnqk,bhrnkd->bhrnqd', p, vb)
    o = o.reshape(b, h, dilation, Lp, dh)[:, :, :, :L].transpose(0, 1, 3, 2, 4)
    lse = lse.reshape(b, h, dilation, Lp)[:, :, :, :L].transpose(0, 1, 3, 2)
    return o.reshape(b, h, t, dh), lse.reshape(b, h, t)


def setup_inputs(seed: int = 0) -> dict:
    key = jax.random.key(seed)
    ks = jax.random.split(key, 16)
    f32 = jnp.float32

    def nrm(k, shape, fan_in):
        return jax.random.normal(k, shape, f32) * (fan_in ** -0.5)

    def gain(k, shape):
        return 1.0 + 0.05 * jax.random.normal(k, shape, f32)

    return {
        "x": jax.random.normal(ks[0], (BATCH, SEQ, D_MODEL), f32),
        "ffn1_norm": gain(ks[1], (DEPTH, D_MODEL)),
        "ffn1_w_in": nrm(ks[2], (DEPTH, D_MODEL, 2 * D_FF), D_MODEL),
        "ffn1_w_out": nrm(ks[3], (DEPTH, D_FF, D_MODEL), D_FF),
        "mix_norm": gain(ks[4], (DEPTH, D_MODEL)),
        "w_in": nrm(ks[5], (DEPTH, D_MODEL, P_IN), D_MODEL),
        "hgrn_lb_logits": 0.5 * jax.random.normal(ks[6], (DEPTH, HG_WK), f32),
        "hgrn_out_norm": gain(ks[7], (DEPTH, HG_WV)),
        "attn_q_norm": gain(ks[8], (DEPTH, ATT_GROUPS, ATT_DH)),
        "attn_k_norm": gain(ks[9], (DEPTH, ATT_GROUPS, ATT_DH)),
        "w_branch_a": nrm(ks[10], (DEPTH, HG_WV, D_MODEL), HG_WV),
        "w_branch_b": nrm(ks[11], (DEPTH, ATT_OUT, D_MODEL), ATT_OUT),
        "w_out": nrm(ks[12], (DEPTH, D_MODEL, D_MODEL), D_MODEL),
        "ffn2_norm": gain(ks[13], (DEPTH, D_MODEL)),
        "ffn2_w_in": nrm(ks[14], (DEPTH, D_MODEL, 2 * D_FF), D_MODEL),
        "ffn2_w_out": nrm(ks[15], (DEPTH, D_FF, D_MODEL), D_FF),
    }


def reference(x, ffn1_norm, ffn1_w_in, ffn1_w_out, mix_norm, w_in, hgrn_lb_logits,
              hgrn_out_norm, attn_q_norm, attn_k_norm, w_branch_a, w_branch_b, w_out,
              ffn2_norm, ffn2_w_in, ffn2_w_out):
    b, t, _ = x.shape
    f32 = jnp.float32
    cos, sin = rope_tables(t)
    lb_all = jnp.cumsum(jax.nn.softmax(hgrn_lb_logits.astype(f32), axis=0), axis=0)
    lb_all = lb_all - lb_all[0:1]
    split_idx = [int(s) for s in np.cumsum(SPLIT_SIZES)[:-1]]

    for l in range(DEPTH):
        x = x + 0.5 * swiglu(rmsnorm(x, ffn1_norm[l]), ffn1_w_in[l], ffn1_w_out[l])

        h = rmsnorm(x, mix_norm[l])
        hq, hf, hi, hg, aq, ak, av, ga, gb = jnp.split(h @ w_in[l], split_idx, axis=-1)

        lb = lb_all[l]
        f = lb + (1.0 - lb) * jax.nn.sigmoid(hf.astype(f32))
        q_a = jax.nn.silu(hq.astype(f32)).reshape(b, t, HG_HEADS, HG_DK)
        k_a = (1.0 - f).reshape(b, t, HG_HEADS, HG_DK)
        v_a = hi.astype(f32).reshape(b, t, HG_HEADS, HG_DV)
        log_f = jnp.log(f).reshape(b, t, HG_HEADS, HG_DK)
        o_a = hgrn2_chunk_scan(q_a, k_a, v_a, log_f)
        o_a = rms(o_a.reshape(b, t, HG_HEADS, HG_DV)).reshape(b, t, HG_WV)
        o_a = o_a * hgrn_out_norm[l].astype(f32) * jax.nn.silu(hg.astype(f32))
        y_a = o_a.astype(x.dtype) @ w_branch_a[l]

        def heads(a):
            return a.reshape(b, t, ATT_GROUPS, ATT_HEADS, ATT_DH).transpose(2, 0, 3, 1, 4).astype(f32)

        qn = attn_q_norm[l].astype(f32)[:, None, None, None, :]
        kn = attn_k_norm[l].astype(f32)[:, None, None, None, :]
        q_b = apply_rope(rms(heads(aq)) * qn, cos, sin)
        k_b = apply_rope(rms(heads(ak)) * kn, cos, sin)
        v_b = heads(av)
        outs, lses = [], []
        for g, (window, dilation) in enumerate(ATT_PATTERNS):
            o_g, lse_g = dilated_window_attention(q_b[g], k_b[g], v_b[g], window, dilation)
            outs.append(o_g)
            lses.append(lse_g)
        alpha = jax.nn.softmax(jnp.stack(lses, axis=0), axis=0)
        o_b = jnp.einsum('gbht,gbhtd->bthd', alpha, jnp.stack(outs, axis=0)).reshape(b, t, ATT_OUT)
        y_b = o_b.astype(x.dtype) @ w_branch_b[l]

        merged = jax.nn.sigmoid(ga) * y_a + jax.nn.sigmoid(gb) * y_b
        x = x + merged @ w_out[l]

        x = x + 0.5 * swiglu(rmsnorm(x, ffn2_norm[l]), ffn2_w_in[l], ffn2_w_out[l])
    return x
```

```cpp
#include <hip/hip_runtime.h>
#include <hip/hip_cooperative_groups.h>
#include <cstdio>
#include <cstdint>
namespace cg = cooperative_groups;

#define LAS __attribute__((address_space(3)))
typedef unsigned short bf16_t;
typedef short bf16x8 __attribute__((ext_vector_type(8)));
typedef short s16x4 __attribute__((ext_vector_type(4)));
typedef float f32x4 __attribute__((ext_vector_type(4)));
typedef float f32x2 __attribute__((ext_vector_type(2)));
typedef unsigned u32x4 __attribute__((ext_vector_type(4)));
typedef unsigned u32x2 __attribute__((ext_vector_type(2)));
typedef __bf16 bf2_t __attribute__((ext_vector_type(2)));

constexpr int BATCH = 4, SEQ = 8192, DM = 1024, MTOK = BATCH * SEQ, DFF = 2816, PIN = 10752;
constexpr int ATW = 1536;
constexpr float EPS = 1e-6f;
constexpr int NWG = 256, NTHR = 512;
constexpr int LDS_BYTES = 147456;

constexpr size_t MiB = 1u << 20;
constexpr size_t WS_SSQ = 1 * MiB;
constexpr size_t WS_COS = 2 * MiB, WS_SIN = 4 * MiB;
constexpr size_t WS_W = 6 * MiB;
constexpr size_t W_1T = WS_W, W_1O = W_1T + 11 * MiB, W_IN = W_1O + 11 * MiB / 2, W_A = W_IN + 21 * MiB, W_B = W_A + 2 * MiB, W_O = W_B + 1 * MiB,
                 W_2T = W_O + 2 * MiB, W_2O = W_2T + 11 * MiB;
constexpr size_t WS_XB = 65 * MiB;
constexpr size_t WS_XL = 129 * MiB;
constexpr size_t WS_R = 193 * MiB;
constexpr size_t WS_HID = WS_R;
constexpr size_t WS_HQ = WS_R, WS_HF = WS_R + 64 * MiB, WS_HI = WS_R + 128 * MiB, WS_HG = WS_R + 192 * MiB;
constexpr size_t WS_US = WS_R + 256 * MiB;
constexpr size_t WS_DT = WS_US + 16 * MiB;
constexpr size_t WS_AQ = WS_R, WS_AK = WS_AQ + 96 * MiB, WS_AV = WS_AK + 96 * MiB;
constexpr size_t WS_HSSQ = 481 * MiB;
constexpr size_t WS_LSE = 485 * MiB;
constexpr size_t WS_DUMMY = 487 * MiB;
constexpr size_t WS_OB = WS_AK;
constexpr size_t WS_T1 = WS_AV;
constexpr size_t WS_T2 = WS_AQ;
static_assert(W_2O + 11 * MiB / 2 <= WS_XB, "weights");
static_assert(WS_DT + 256 * 128 * 4 <= 481 * MiB && WS_AV + 96 * MiB == 481 * MiB && WS_HID + (size_t)MTOK * DFF * 2 <= 481 * MiB, "ws");

__device__ __forceinline__ float bf2f(bf16_t v) { return __uint_as_float(((unsigned)v) << 16); }
__device__ __forceinline__ float bflo(unsigned u) { return __uint_as_float(u << 16); }
__device__ __forceinline__ float bfhi(unsigned u) { return __uint_as_float(u & 0xffff0000u); }
__device__ __forceinline__ unsigned pk2(float lo, float hi) { f32x2 v = {lo, hi}; bf2_t b = __builtin_convertvector(v, bf2_t); return __builtin_bit_cast(unsigned, b); }
__device__ __forceinline__ bf16_t f2bf(float f) { return (bf16_t)(pk2(f, 0.f) & 0xffffu); }
__device__ __forceinline__ float fast_rcp(float x) { return __builtin_amdgcn_rcpf(x); }
__device__ __forceinline__ float sigmoidf_(float x) { return fast_rcp(1.f + __expf(-x)); }
__device__ __forceinline__ float siluf_(float x) { return x * sigmoidf_(x); }
__device__ __forceinline__ int opaque_tid(int wv) { int l; asm volatile("v_mbcnt_lo_u32_b32 %0, -1, 0\n\tv_mbcnt_hi_u32_b32 %0, -1, %0" : "=v"(l)); return (wv << 6) | l; }
template <class Tp> __device__ __forceinline__ Tp* opaque_ptr(Tp* p) { asm volatile("" : "+s"(p)); return p; }
__device__ __forceinline__ float shx(float v, int lane, int mask) { return __int_as_float(__builtin_amdgcn_ds_bpermute((lane ^ mask) << 2, __float_as_int(v))); }
__device__ __forceinline__ bf16x8 lds_ld16(LAS unsigned char* p) { return *(const LAS bf16x8*)p; }
__device__ __forceinline__ f32x4 mfma16(bf16x8 a, bf16x8 b, f32x4 c) { return __builtin_amdgcn_mfma_f32_16x16x32_bf16(a, b, c, 0, 0, 0); }

namespace pg8 {
constexpr int BM = 256, BK = 64, HALF = 128, HTB = HALF * BK * 2, STAGE_BYTES = 8 * HTB, NXCD = 8, WGM = 8;
__host__ __device__ __forceinline__ int lds_byte(int r, int c) { const int st = (r >> 4) * 2 + (c >> 5), rr = r & 15, cc = c & 31, ob = rr * 64 + cc * 2; return st * 1024 + (ob ^ (((ob >> 9) & 1) << 5)); }
__host__ __device__ __forceinline__ void stage_rc(int b, int& R, int& C) { const int st = b / 1024, sb = b % 1024, swz = sb ^ (((sb >> 9) & 1) << 5); R = (st >> 1) * 16 + swz / 64; C = (st & 1) * 32 + (swz % 64) / 2; }
__host__ __device__ __forceinline__ int perm32(int rho) { const int n = rho >> 4, i = rho & 15; return 8 * (i >> 2) + 4 * n + (i & 3); }
__host__ __device__ __forceinline__ int permB_std(int R) { return (R & ~31) + perm32(R & 31); }
__host__ __device__ __forceinline__ int permB_rope(int R) { const int wc = R >> 5, n = (R >> 4) & 1, i = R & 15; return 64 * n + 16 * wc + i; }

__host__ __device__ __forceinline__ int permB_wide(int R) { const int j32 = perm32(R & 31); return 64 * (R >> 5) + 16 * (j32 >> 3) + (j32 & 7); }
__host__ __device__ __forceinline__ int permB_rope2(int R) { return 128 * (R >> 6) + 32 * ((R >> 5) & 1) + perm32(R & 31); }
struct Unit { int pm, pn; };
struct Gemm { const bf16_t* A; const bf16_t* Bt; int M, N, K; };
struct StaticOrder {
    int nM, nN, nwg, G, c;
    __device__ void init(int M, int N, int G_, int c_) { nM = M / BM; nN = N / BM; nwg = nM * nN; G = G_; c = c_; }
    __device__ bool next(int i, Unit& u) const {
        const long L = (long)i * G + c; if (L >= nwg) return false;
        int wgid = (int)L; { const int q = nwg / NXCD, r = nwg % NXCD, xcd = wgid % NXCD, off = wgid / NXCD; wgid = (xcd < r ? xcd * (q + 1) : r * (q + 1) + (xcd - r) * q) + off; }
        const int nig = WGM * nN, gid = wgid / nig, fm = gid * WGM, gsz = (nM - fm) < WGM ? (nM - fm) : WGM;
        u.pm = fm + ((wgid % nig) % gsz); u.pn = (wgid % nig) / gsz; return true;
    }
};

template <class Epi, class Sched>
__device__ __forceinline__ void gemm_phase(int wv, LAS unsigned char* lds, const Gemm g, const Sched& S, const Epi& E) {
    const int tid = opaque_tid(wv), wid = __builtin_amdgcn_readfirstlane(tid >> 6), lane = tid & 63, wr = wid >> 2, wc = wid & 3, fr = lane & 15, fq = lane >> 4;
    const int K = g.K, nt = K / BK;
    unsigned voffA[2], voffB[2];
#pragma unroll
    for (int i = 0; i < 2; ++i) { int R, C; stage_rc(tid * 16 + i * 8192, R, C); const int Rb = Epi::permB(R);
        voffA[i] = (unsigned)(R * K + C) * 2u; voffB[i] = (unsigned)(Rb * K + C) * 2u; }
    const size_t kstep = (size_t)(BK * 2);
    const size_t hstep = (size_t)HALF * K * 2;
    const size_t tstep = 2 * hstep;
    const size_t hstepB = (size_t)Epi::BHALF * K * 2;
    const size_t tstepB = (size_t)Epi::BTILE * K * 2;
    const unsigned ldsw = (unsigned)wid * 1024u;
    const int aoff = lds_byte(wr * 64 + fr, fq * 8), boff = lds_byte(wc * 32 + fr, fq * 8);
#define PG8_SA(b, h) (((b) * 2 + (h)) * HTB)
#define PG8_SB(b, h) ((4 + (b) * 2 + (h)) * HTB)
#define PG8_STAGE(bufoff, gbase, voff) do { _Pragma("unroll") for (int _i = 0; _i < 2; ++_i) \
        __builtin_amdgcn_global_load_lds((const unsigned*)((const char*)(gbase) + (voff)[_i]), (LAS unsigned*)(lds + (bufoff) + ldsw + _i * 8192), 16, 0, 0); } while (0)
#define PG8_LDA(dst, b, h) do { _Pragma("unroll") for (int m = 0; m < 4; ++m) _Pragma("unroll") for (int k = 0; k < 2; ++k) dst[m][k] = *(const LAS bf16x8*)(lds + PG8_SA(b, h) + aoff + m * 2048 + k * 1024); } while (0)
#define PG8_LDB(dst, b, h) do { _Pragma("unroll") for (int n = 0; n < 2; ++n) _Pragma("unroll") for (int k = 0; k < 2; ++k) dst[n][k] = *(const LAS bf16x8*)(lds + PG8_SB(b, h) + boff + n * 2048 + k * 1024); } while (0)
#define PG8_MMA(ai, bj, At, Bt) do { __builtin_amdgcn_s_setprio(1); _Pragma("unroll") for (int m = 0; m < 4; ++m) _Pragma("unroll") for (int n = 0; n < 2; ++n) _Pragma("unroll") for (int k = 0; k < 2; ++k) \
        acc[ai][bj][m][n] = __builtin_amdgcn_mfma_f32_16x16x32_bf16(Bt[n][k], At[m][k], acc[ai][bj][m][n], 0, 0, 0); __builtin_amdgcn_s_setprio(0); } while (0)
#define PG8_WAIT_V(n) asm volatile("s_waitcnt vmcnt(" #n ")" ::: "memory")
#define PG8_WAIT_L(n) asm volatile("s_waitcnt lgkmcnt(" #n ")" ::: "memory")
#define PG8_BAR __builtin_amdgcn_s_barrier()
#define PG8_SCHED __builtin_amdgcn_sched_barrier(0)
    Unit cur, nxt; int ui = 0;
    if (!S.next(0, cur)) return;
    f32x4 acc[2][2][4][2];
#pragma unroll
    for (int a = 0; a < 2; ++a)
#pragma unroll
        for (int b = 0; b < 2; ++b)
#pragma unroll
            for (int m = 0; m < 4; ++m)
#pragma unroll
                for (int n = 0; n < 2; ++n) acc[a][b][m][n] = (f32x4){0.f, 0.f, 0.f, 0.f};
    bf16x8 At[4][2], B0[2][2], B1[2][2];
    const char* cA = (const char*)g.A + (size_t)cur.pm * tstep; const char* cB = (const char*)g.Bt + (size_t)cur.pn * tstepB;
    PG8_STAGE(PG8_SB(0, 0), cB, voffB); PG8_STAGE(PG8_SB(0, 1), cB + hstepB, voffB); PG8_STAGE(PG8_SA(0, 0), cA, voffA); PG8_STAGE(PG8_SA(0, 1), cA + hstep, voffA);
    if (wr == 1) PG8_BAR;
    PG8_WAIT_V(2); PG8_BAR;
    PG8_STAGE(PG8_SB(1, 0), cB + kstep, voffB); PG8_STAGE(PG8_SA(1, 0), cA + kstep, voffA); PG8_STAGE(PG8_SB(1, 1), cB + hstepB + kstep, voffB);
    PG8_WAIT_V(6); PG8_BAR;
    for (;;) {
        const bool has_next = S.next(ui + 1, nxt);
        const char* nA = has_next ? (const char*)g.A + (size_t)nxt.pm * tstep : cA; const char* nB = has_next ? (const char*)g.Bt + (size_t)nxt.pn * tstepB : cB;
        for (int t = 0; t < nt; t += 2) {
            const bool last = (t == nt - 2);
            const char* a1 = cA + (size_t)(t + 1) * kstep;
            const char* a2 = last ? nA : cA + (size_t)(t + 2) * kstep; const char* b2 = last ? nB : cB + (size_t)(t + 2) * kstep;
            const char* a3 = a2 + kstep; const char* b3 = b2 + kstep;
            PG8_LDB(B0, 0, 0); PG8_LDB(B1, 0, 1); PG8_SCHED; PG8_LDA(At, 0, 0); PG8_STAGE(PG8_SA(1, 1), a1 + hstep, voffA);
            PG8_WAIT_V(8); PG8_WAIT_L(0); PG8_BAR; PG8_MMA(0, 0, At, B0); PG8_MMA(0, 1, At, B1); PG8_BAR; PG8_SCHED;
            PG8_LDA(At, 0, 1); PG8_STAGE(PG8_SB(0, 0), b2, voffB); PG8_STAGE(PG8_SB(0, 1), b2 + hstepB, voffB); PG8_STAGE(PG8_SA(0, 0), a2, voffA);
            PG8_WAIT_V(8); PG8_WAIT_L(0); PG8_BAR; PG8_MMA(1, 0, At, B0); PG8_MMA(1, 1, At, B1); PG8_BAR; PG8_SCHED;
            PG8_LDB(B0, 1, 0); PG8_LDB(B1, 1, 1); PG8_SCHED; PG8_LDA(At, 1, 0); PG8_STAGE(PG8_SA(0, 1), a2 + hstep, voffA);
            PG8_WAIT_V(8); PG8_WAIT_L(0); PG8_BAR; PG8_MMA(0, 0, At, B0); PG8_MMA(0, 1, At, B1); PG8_BAR; PG8_SCHED;
            PG8_LDA(At, 1, 1); PG8_STAGE(PG8_SB(1, 0), b3, voffB); PG8_STAGE(PG8_SB(1, 1), b3 + hstepB, voffB); PG8_STAGE(PG8_SA(1, 0), a3, voffA);
            PG8_WAIT_V(8); PG8_WAIT_L(0); PG8_BAR; PG8_MMA(1, 0, At, B0); PG8_MMA(1, 1, At, B1); PG8_BAR; PG8_SCHED;
        }
        if (wr == 0) PG8_BAR;
        E(acc, cur, wr, wc, fr, fq);
        if (!has_next) break;
#pragma unroll
        for (int a = 0; a < 2; ++a)
#pragma unroll
            for (int b = 0; b < 2; ++b)
#pragma unroll
                for (int m = 0; m < 4; ++m)
#pragma unroll
                    for (int n = 0; n < 2; ++n) acc[a][b][m][n] = (f32x4){0.f, 0.f, 0.f, 0.f};
        cur = nxt; cA = nA; cB = nB; ++ui;
        if (wr == 1) PG8_BAR;
    }
    PG8_WAIT_V(0);
    PG8_BAR;
#undef PG8_SA
#undef PG8_SB
#undef PG8_STAGE
#undef PG8_LDA
#undef PG8_LDB
#undef PG8_MMA
#undef PG8_WAIT_V
#undef PG8_WAIT_L
#undef PG8_BAR
#undef PG8_SCHED
}
}
struct PairOrder { pg8::StaticOrder S; __device__ bool next(int i, pg8::Unit& u) const { if (!S.next(i >> 1, u)) return false; u.pn = 2 * u.pn + (i & 1); return true; } };
using pg8::Unit;
typedef f32x4 AccT[2][2][4][2];

__device__ __forceinline__ float rstd_row(const float* ssq, int row) { return rsqrtf(ssq[row] * (1.f / 1024.f) + EPS); }

struct EpiFfnIn {
    static constexpr int BHALF = 128, BTILE = 256;
    static __device__ __forceinline__ int permB(int R) { return pg8::permB_std(R); }
    bf16_t* H; const float* ssq;
    __device__ __forceinline__ void operator()(const AccT& acc, const Unit& u, int wr, int wc, int fr, int fq) const {
        const int row0 = u.pm * 256 + wr * 64 + fr, col0 = u.pn * 128 + wc * 32 + 8 * fq;
        float rsv[8];
#pragma unroll
        for (int idx = 0; idx < 8; ++idx) rsv[idx] = ssq[row0 + (idx >> 2) * 128 + (idx & 3) * 16];
#pragma unroll
        for (int ai = 0; ai < 2; ++ai)
#pragma unroll
            for (int m = 0; m < 4; ++m) {
                const int row = row0 + ai * 128 + m * 16; const float rs = rsqrtf(rsv[ai * 4 + m] * (1.f / 1024.f) + EPS);
                float h[8];
#pragma unroll
                for (int n = 0; n < 2; ++n)
#pragma unroll
                    for (int j = 0; j < 4; ++j) { const float a = acc[ai][0][m][n][j] * rs, b = acc[ai][1][m][n][j] * rs; h[n * 4 + j] = siluf_(a) * b; }
                u32x4 w; w.x = pk2(h[0], h[1]); w.y = pk2(h[2], h[3]); w.z = pk2(h[4], h[5]); w.w = pk2(h[6], h[7]);
                *(u32x4*)(H + (size_t)row * DFF + col0) = w;
            }
    }
};

#define EPI_SCHED() __builtin_amdgcn_sched_barrier(0)
#define LANE_ (fq * 16 + fr)
__device__ __forceinline__ unsigned pk_lo8(float a, float b, float c, float d) { int w = 0; w = __builtin_amdgcn_cvt_pk_fp8_f32(a * 512.f, b * 512.f, w, false); w = __builtin_amdgcn_cvt_pk_fp8_f32(c * 512.f, d * 512.f, w, true); return (unsigned)w; }
__device__ __forceinline__ f32x4 un_lo8(unsigned w) { return (f32x4){__builtin_amdgcn_cvt_f32_fp8((int)w, 0), __builtin_amdgcn_cvt_f32_fp8((int)w, 1), __builtin_amdgcn_cvt_f32_fp8((int)w, 2), __builtin_amdgcn_cvt_f32_fp8((int)w, 3)} * (1.f / 512.f); }
struct EpiResid {
    static constexpr int BHALF = 8, BTILE = 256;
    static __device__ __forceinline__ int permB(int R) { return pg8::permB_wide(R); }
    float* OUT; bf16_t* XB; unsigned char* XL; float* ssq_next; float scale; bool last;
    __device__ __forceinline__ void operator()(const AccT& acc, const Unit& u, int wr, int wc, int fr, int fq) const {
        const int row0 = u.pm * 256 + wr * 64 + fr, col0 = u.pn * 256 + wc * 64 + 16 * fq;
        const size_t off0 = (size_t)row0 * DM + col0;
        u32x4 hr[4][2], lr[4];
#pragma unroll
        for (int i = 0; i < 4; ++i) { const size_t o = off0 + (size_t)(i * 16) * DM; hr[i][0] = *(const u32x4*)(XB + o); hr[i][1] = *(const u32x4*)(XB + o + 8); lr[i] = *(const u32x4*)(XL + o); }
        EPI_SCHED();
#pragma unroll
        for (int idx = 0; idx < 8; ++idx) {
            const int ai = idx >> 2, m = idx & 3, rofs = ai * 128 + m * 16;
            const int row = row0 + rofs; float s = 0.f;
            const size_t off = off0 + (size_t)rofs * DM;
            const u32x4 h0 = hr[idx & 3][0], h1 = hr[idx & 3][1], l0 = lr[idx & 3];
            if (idx + 4 < 8) { const size_t o = off0 + (size_t)(128 + (idx & 3) * 16) * DM;
                hr[idx & 3][0] = *(const u32x4*)(XB + o); hr[idx & 3][1] = *(const u32x4*)(XB + o + 8); lr[idx & 3] = *(const u32x4*)(XL + o); }
            f32x4 x[4];
            x[0] = (f32x4){bflo(h0.x), bfhi(h0.x), bflo(h0.y), bfhi(h0.y)} + un_lo8(l0.x);
            x[1] = (f32x4){bflo(h0.z), bfhi(h0.z), bflo(h0.w), bfhi(h0.w)} + un_lo8(l0.y);
            x[2] = (f32x4){bflo(h1.x), bfhi(h1.x), bflo(h1.y), bfhi(h1.y)} + un_lo8(l0.z);
            x[3] = (f32x4){bflo(h1.z), bfhi(h1.z), bflo(h1.w), bfhi(h1.w)} + un_lo8(l0.w);
#pragma unroll
            for (int q = 0; q < 4; ++q) { x[q] = x[q] + scale * acc[ai][q >> 1][m][q & 1];
                s += (x[q][0] * x[q][0] + x[q][1] * x[q][1]) + (x[q][2] * x[q][2] + x[q][3] * x[q][3]); }
            if (last) { float* p = OUT + off;
#pragma unroll
                for (int q = 0; q < 4; ++q) *(f32x4*)(p + 4 * q) = x[q];
            } else {
                u32x4 w0, w1, v0;
                w0.x = pk2(x[0][0], x[0][1]); w0.y = pk2(x[0][2], x[0][3]); w0.z = pk2(x[1][0], x[1][1]); w0.w = pk2(x[1][2], x[1][3]);
                w1.x = pk2(x[2][0], x[2][1]); w1.y = pk2(x[2][2], x[2][3]); w1.z = pk2(x[3][0], x[3][1]); w1.w = pk2(x[3][2], x[3][3]);
                v0.x = pk_lo8(x[0][0] - bflo(w0.x), x[0][1] - bfhi(w0.x), x[0][2] - bflo(w0.y), x[0][3] - bfhi(w0.y));
                v0.y = pk_lo8(x[1][0] - bflo(w0.z), x[1][1] - bfhi(w0.z), x[1][2] - bflo(w0.w), x[1][3] - bfhi(w0.w));
                v0.z = pk_lo8(x[2][0] - bflo(w1.x), x[2][1] - bfhi(w1.x), x[2][2] - bflo(w1.y), x[2][3] - bfhi(w1.y));
                v0.w = pk_lo8(x[3][0] - bflo(w1.z), x[3][1] - bfhi(w1.z), x[3][2] - bflo(w1.w), x[3][3] - bfhi(w1.w));
                u32x4* xb = (u32x4*)(XB + off); xb[0] = w0; xb[1] = w1;
                *(u32x4*)(XL + off) = v0;
                s += shx(s, LANE_, 16); s += shx(s, LANE_, 32);
                if (fq == 0) atomicAdd(ssq_next + row, s);
            }
            EPI_SCHED();
        }
    }
};

struct EpiProjA {
    static constexpr int BHALF = 8, BTILE = 256;
    static __device__ __forceinline__ int permB(int R) { return pg8::permB_wide(R); }
    bf16_t* O; const float* ssq;
    __device__ __forceinline__ void operator()(const AccT& acc, const Unit& u, int wr, int wc, int fr, int fq) const {
        const int seg = u.pn >> 2; const bool act = (seg == 0) || (seg == 3);
        bf16_t* base = O + (size_t)seg * ((size_t)MTOK * DM);
        const int row0 = u.pm * 256 + wr * 64 + fr, col0 = (u.pn & 3) * 256 + wc * 64 + 16 * fq;
        float rsv[8];
#pragma unroll
        for (int idx = 0; idx < 8; ++idx) rsv[idx] = ssq[row0 + (idx >> 2) * 128 + (idx & 3) * 16];
#pragma unroll
        for (int ai = 0; ai < 2; ++ai)
#pragma unroll
            for (int m = 0; m < 4; ++m) {
                const int row = row0 + ai * 128 + m * 16; const float rs = rsqrtf(rsv[ai * 4 + m] * (1.f / 1024.f) + EPS);
                u32x4 w[2];
#pragma unroll
                for (int bj = 0; bj < 2; ++bj) {
                    float v[8];
#pragma unroll
                    for (int n = 0; n < 2; ++n)
#pragma unroll
                        for (int j = 0; j < 4; ++j) { const float a = acc[ai][bj][m][n][j] * rs; v[n * 4 + j] = act ? siluf_(a) : a; }
                    w[bj].x = pk2(v[0], v[1]); w[bj].y = pk2(v[2], v[3]); w[bj].z = pk2(v[4], v[5]); w[bj].w = pk2(v[6], v[7]);
                }
                u32x4* op = (u32x4*)(base + (size_t)row * DM + col0); op[0] = w[0]; op[1] = w[1];
            }
    }
};

struct EpiProjB {
    static constexpr int BHALF = 64, BTILE = 256;
    static __device__ __forceinline__ int permB(int R) { return pg8::permB_rope2(R); }
    bf16_t* O; const float* ssq; float* hssq; const float* qn; const float* kn; const float* cosT; const float* sinT;
    __device__ __forceinline__ void operator()(const AccT& acc, const Unit& u, int wr, int wc, int fr, int fq) const {
        const int seg = u.pn / 6, hp = u.pn - seg * 6;
        bf16_t* base = O + (size_t)seg * ((size_t)MTOK * ATW);
        const int row0 = u.pm * 256 + wr * 64 + fr, c0 = (wc & 1) * 32 + 8 * fq, head = hp * 2 + (wc >> 1);
        const float* gn = ((seg == 0) ? qn : kn) + (head >> 2) * 128 + c0;
        float rsn[2]; rsn[0] = ssq[row0]; rsn[1] = ssq[row0 + 16];
        const bool rope = seg < 2;
        f32x4 g1a, g1b, g2a, g2b;
        if (rope) { g1a = *(const f32x4*)(gn); g1b = *(const f32x4*)(gn + 4); g2a = *(const f32x4*)(gn + 64); g2b = *(const f32x4*)(gn + 68); }
        const int t0 = row0 & (SEQ - 1);
        const float* cb0 = cosT + (size_t)t0 * 64 + c0; const float* sb0 = sinT + (size_t)t0 * 64 + c0;
        f32x4 tca, tcb, tsa, tsb;
        if (rope) { tca = *(const f32x4*)(cb0); tcb = *(const f32x4*)(cb0 + 4); tsa = *(const f32x4*)(sb0); tsb = *(const f32x4*)(sb0 + 4); }
#pragma unroll
        for (int idx = 0; idx < 8; ++idx) {
            const int ai = idx >> 2, m = idx & 3, rofs = ai * 128 + m * 16;
            const int row = row0 + rofs; const float rs = rsqrtf(rsn[idx & 1] * (1.f / 1024.f) + EPS);
            if (idx + 2 < 8) rsn[idx & 1] = ssq[row0 + ((idx + 2) >> 2) * 128 + ((idx + 2) & 3) * 16];
            float v1[8], v2[8];
#pragma unroll
            for (int n = 0; n < 2; ++n)
#pragma unroll
                for (int j = 0; j < 4; ++j) { v1[n * 4 + j] = acc[ai][0][m][n][j] * rs; v2[n * 4 + j] = acc[ai][1][m][n][j] * rs; }
            if (rope) {
                float s = 0.f;
#pragma unroll
                for (int e = 0; e < 8; ++e) s += v1[e] * v1[e] + v2[e] * v2[e];
                s += shx(s, LANE_, 16); s += shx(s, LANE_, 32);
                if (fq == 0) atomicAdd(hssq + (size_t)row * 24 + seg * 12 + head, s);
#pragma unroll
                for (int e = 0; e < 8; ++e) {
                    const float cs = e < 4 ? tca[e & 3] : tcb[e & 3], sn = e < 4 ? tsa[e & 3] : tsb[e & 3];
                    const float y1 = v1[e] * (e < 4 ? g1a[e & 3] : g1b[e & 3]), y2 = v2[e] * (e < 4 ? g2a[e & 3] : g2b[e & 3]);
                    v1[e] = y1 * cs - y2 * sn; v2[e] = y2 * cs + y1 * sn;
                }
                EPI_SCHED();
                if (idx + 1 < 8) { const int ro = ((idx + 1) >> 2) * 128 + ((idx + 1) & 3) * 16;
                    tca = *(const f32x4*)(cb0 + ro * 64); tcb = *(const f32x4*)(cb0 + ro * 64 + 4); tsa = *(const f32x4*)(sb0 + ro * 64); tsb = *(const f32x4*)(sb0 + ro * 64 + 4); }
                EPI_SCHED();
            }
            u32x4 w1, w2; w1.x = pk2(v1[0], v1[1]); w1.y = pk2(v1[2], v1[3]); w1.z = pk2(v1[4], v1[5]); w1.w = pk2(v1[6], v1[7]);
            w2.x = pk2(v2[0], v2[1]); w2.y = pk2(v2[2], v2[3]); w2.z = pk2(v2[4], v2[5]); w2.w = pk2(v2[6], v2[7]);
            bf16_t* p = base + (size_t)row * ATW + head * 128 + c0;
            *(u32x4*)p = w1; *(u32x4*)(p + 64) = w2;
        }
    }
};

struct EpiStoreBf16 {
    static constexpr int BHALF = 8, BTILE = 256;
    static __device__ __forceinline__ int permB(int R) { return pg8::permB_wide(R); }
    bf16_t* T;
    __device__ __forceinline__ void operator()(const AccT& acc, const Unit& u, int wr, int wc, int fr, int fq) const {
        const int row0 = u.pm * 256 + wr * 64 + fr, col0 = u.pn * 256 + wc * 64 + 16 * fq;
#pragma unroll
        for (int ai = 0; ai < 2; ++ai)
#pragma unroll
            for (int m = 0; m < 4; ++m) {
                u32x4 w[2];
#pragma unroll
                for (int bj = 0; bj < 2; ++bj) { w[bj].x = pk2(acc[ai][bj][m][0][0], acc[ai][bj][m][0][1]); w[bj].y = pk2(acc[ai][bj][m][0][2], acc[ai][bj][m][0][3]); w[bj].z = pk2(acc[ai][bj][m][1][0], acc[ai][bj][m][1][1]); w[bj].w = pk2(acc[ai][bj][m][1][2], acc[ai][bj][m][1][3]); }
                u32x4* op = (u32x4*)(T + (size_t)(row0 + ai * 128 + m * 16) * DM + col0); op[0] = w[0]; op[1] = w[1];
            }
    }
};
struct EpiGateMerge {
    static constexpr int BHALF = 1024, BTILE = 128;
    static __device__ __forceinline__ int permB(int R) { return pg8::permB_std(R); }
    bf16_t* T1; const bf16_t* T2; const float* ssq;
    __device__ __forceinline__ void operator()(const AccT& acc, const Unit& u, int wr, int wc, int fr, int fq) const {
        const int row0 = u.pm * 256 + wr * 64 + fr, col0 = u.pn * 128 + wc * 32 + 8 * fq;
        const size_t off0 = (size_t)row0 * DM + col0;
        float rsv[8];
#pragma unroll
        for (int idx = 0; idx < 8; ++idx) rsv[idx] = ssq[row0 + (idx >> 2) * 128 + (idx & 3) * 16];
        u32x4 ra[4], rb[4];
#pragma unroll
        for (int i = 0; i < 4; ++i) { const size_t o = off0 + (size_t)(i * 16) * DM; ra[i] = *(const u32x4*)(T1 + o); rb[i] = *(const u32x4*)(T2 + o); }
        EPI_SCHED();
#pragma unroll
        for (int idx = 0; idx < 8; ++idx) {
            const int ai = idx >> 2, m = idx & 3;
            const size_t off = off0 + (size_t)(ai * 128 + m * 16) * DM;
            const float rs = rsqrtf(rsv[idx] * (1.f / 1024.f) + EPS);
            const u32x4 ta = ra[idx & 3], tb = rb[idx & 3];
            if (idx + 4 < 8) { const size_t o = off0 + (size_t)(128 + (idx & 3) * 16) * DM; ra[idx & 3] = *(const u32x4*)(T1 + o); rb[idx & 3] = *(const u32x4*)(T2 + o); }
            const float ya[8] = {bflo(ta.x), bfhi(ta.x), bflo(ta.y), bfhi(ta.y), bflo(ta.z), bfhi(ta.z), bflo(ta.w), bfhi(ta.w)};
            const float yb[8] = {bflo(tb.x), bfhi(tb.x), bflo(tb.y), bfhi(tb.y), bflo(tb.z), bfhi(tb.z), bflo(tb.w), bfhi(tb.w)};
            float o[8];
#pragma unroll
            for (int n = 0; n < 2; ++n)
#pragma unroll
                for (int j = 0; j < 4; ++j) { const int e = n * 4 + j; o[e] = sigmoidf_(acc[ai][0][m][n][j] * rs) * ya[e] + sigmoidf_(acc[ai][1][m][n][j] * rs) * yb[e]; }
            u32x4 w; w.x = pk2(o[0], o[1]); w.y = pk2(o[2], o[3]); w.z = pk2(o[4], o[5]); w.w = pk2(o[6], o[7]);
            *(u32x4*)(T1 + off) = w;
            EPI_SCHED();
        }
    }
};

struct Args {
    const float* in[16];
    float* out; unsigned char* ws;
};

__device__ __forceinline__ void transpose_item(const float* W, int K, int Nsrc, const float* gain, bf16_t* WT, int dst_row0, int src_col0, int k0, LAS float* scr, int lane) {
#pragma unroll 8
    for (int i = 0; i < 32; ++i) { const int kk = 2 * i + (lane >> 5); const float g = gain ? gain[k0 + kk] : 1.f; scr[kk * 33 + (lane & 31)] = W[(size_t)(k0 + kk) * Nsrc + src_col0 + (lane & 31)] * g; }
    asm volatile("s_waitcnt lgkmcnt(0)" ::: "memory");
    const int c = lane & 7;
#pragma unroll
    for (int j = 0; j < 4; ++j) { const int n = (lane >> 3) + 8 * j; const LAS float* s = scr + (8 * c) * 33 + n;
        u32x4 o; o.x = pk2(s[0 * 33], s[1 * 33]); o.y = pk2(s[2 * 33], s[3 * 33]); o.z = pk2(s[4 * 33], s[5 * 33]); o.w = pk2(s[6 * 33], s[7 * 33]);
        *(u32x4*)(WT + (size_t)(dst_row0 + n) * K + k0 + 8 * c) = o; }
    asm volatile("s_waitcnt lgkmcnt(0)" ::: "memory");
}

__device__ __forceinline__ void convert_weights(int wv, const Args& a, int l, LAS unsigned char* lds) {
    const int tid = opaque_tid(wv), lane = tid & 63, wave = tid >> 6;
    LAS float* scr = (LAS float*)(lds + wave * 16384);
    unsigned char* ws = opaque_ptr(a.ws);
    const int gw = blockIdx.x * 8 + wave, NGW = NWG * 8;
    constexpr int I1 = 16 * 176, I1O = 44 * 32, IIN = 16 * 336, IA = 16 * 32, IB = 8 * 32, IO = 16 * 32;
    constexpr int NIT = 2 * I1 + 2 * I1O + IIN + IA + IB + IO;
    for (int it = gw; it < NIT; it += NGW) {
        int r = it;
        if (r < 2 * I1) {
            const int which = r / I1; r -= which * I1;
            const float* W = (which ? a.in[14] : a.in[2]) + (size_t)l * DM * 2 * DFF; const float* gn = (which ? a.in[13] : a.in[1]) + l * DM;
            bf16_t* WT = (bf16_t*)(ws + (which ? W_2T : W_1T));
            const int kb = r / 176, nb = r % 176, n0 = nb * 32, pn = n0 >> 8, bj = (n0 >> 7) & 1, i0 = n0 & 127;
            transpose_item(W, DM, 2 * DFF, gn, WT, n0, bj * DFF + 128 * pn + i0, kb * 64, scr, lane); continue; }
        r -= 2 * I1;
        if (r < 2 * I1O) {
            const int which = r / I1O; r -= which * I1O;
            const float* W = (which ? a.in[15] : a.in[3]) + (size_t)l * DFF * DM; bf16_t* WT = (bf16_t*)(ws + (which ? W_2O : W_1O));
            const int kb = r / 32, nb = r % 32;
            transpose_item(W, DFF, DM, nullptr, WT, nb * 32, nb * 32, kb * 64, scr, lane); continue; }
        r -= 2 * I1O;
        if (r < IIN) { const float* W = a.in[5] + (size_t)l * DM * PIN; const float* gn = a.in[4] + l * DM; bf16_t* WT = (bf16_t*)(ws + W_IN);
            const int kb = r / 336, nb = r % 336;
            transpose_item(W, DM, PIN, gn, WT, nb * 32, nb * 32, kb * 64, scr, lane); continue; }
        r -= IIN;
        if (r < IA) { const float* W = a.in[10] + (size_t)l * DM * DM; bf16_t* WT = (bf16_t*)(ws + W_A); const int kb = r / 32, nb = r % 32;
            transpose_item(W, DM, DM, nullptr, WT, nb * 32, nb * 32, kb * 64, scr, lane); continue; }
        r -= IA;
        if (r < IB) { const float* W = a.in[11] + (size_t)l * 512 * DM; bf16_t* WT = (bf16_t*)(ws + W_B); const int kb = r / 32, nb = r % 32;
            transpose_item(W, 512, DM, nullptr, WT, nb * 32, nb * 32, kb * 64, scr, lane); continue; }
        r -= IB;
        { const float* W = a.in[12] + (size_t)l * DM * DM; bf16_t* WT = (bf16_t*)(ws + W_O); const int kb = r / 32, nb = r % 32;
            transpose_item(W, DM, DM, nullptr, WT, nb * 32, nb * 32, kb * 64, scr, lane); }
    }
}

__device__ __forceinline__ void prologue_x(int wv, const Args& a) {
    const int tid = opaque_tid(wv), lane = tid & 63, wave = tid >> 6;
    const int gw = blockIdx.x * 8 + wave, NGW = NWG * 8;
    const int gt = blockIdx.x * NTHR + tid, GT = NWG * NTHR;
    float* ssq = (float*)(a.ws + WS_SSQ);
    bf16_t* XB = (bf16_t*)(a.ws + WS_XB);
    for (int i = gt; i < 6 * MTOK; i += GT) ssq[MTOK + i] = 0.f;
    float* cosT = (float*)(a.ws + WS_COS); float* sinT = (float*)(a.ws + WS_SIN);
    for (int i = gt; i < SEQ * 64; i += GT) { const int t = i >> 6, j = i & 63; const double inv = exp(-(double)j * (9.210340371976184 / 64.0)); double s, c; sincos((double)t * inv, &s, &c); cosT[i] = (float)c; sinT[i] = (float)s; }
    for (int m = gw; m < MTOK; m += NGW) {
        const f32x4* xr = (const f32x4*)(a.in[0] + (size_t)m * DM) + lane;
        u32x2* xb = (u32x2*)(XB + (size_t)m * DM) + lane; unsigned* xl = (unsigned*)((unsigned char*)(a.ws + WS_XL) + (size_t)m * DM) + lane;
        float s = 0.f;
#pragma unroll
        for (int j = 0; j < 4; ++j) { const f32x4 v = xr[64 * j]; u32x2 w; w.x = pk2(v[0], v[1]); w.y = pk2(v[2], v[3]); xb[64 * j] = w; xl[64 * j] = pk_lo8(v[0] - bflo(w.x), v[1] - bfhi(w.x), v[2] - bflo(w.y), v[3] - bfhi(w.y)); s += (v[0] * v[0] + v[1] * v[1]) + (v[2] * v[2] + v[3] * v[3]); }
#pragma unroll
        for (int o = 1; o < 64; o <<= 1) s += shx(s, lane, o);
        if (lane == 0) ssq[m] = s;
    }
}

constexpr int HG_QH = 0, HG_KH = 17408, HG_EM = 34816  , HG_KTT = 52224, HG_VTT = 70656, HG_AM = 89088, HG_ST = 98304, HG_TOT = 133120, HG_DV = 135168, HG_SSQP = 135680;
template <bool FULL>
__device__ __forceinline__ void hgrn_pass(int wv, const Args& a, int l, LAS unsigned char* lds, int item, bool dmy) {
    const int tid = opaque_tid(wv), lane = tid & 63, wid = __builtin_amdgcn_readfirstlane(tid >> 6), fr = lane & 15, fq = lane >> 4;
    const int ch = tid & 127, seg = __builtin_amdgcn_readfirstlane(tid >> 7);
    const int b = item >> 6, h = (item >> 3) & 7, p = item & 7;
    const size_t row_base = (size_t)b * SEQ + (size_t)p * 1024;
    const bf16_t* HQ = (const bf16_t*)(a.ws + WS_HQ); const bf16_t* HF = (const bf16_t*)(a.ws + WS_HF); const bf16_t* HI = (const bf16_t*)(a.ws + WS_HI); const bf16_t* HGt = (const bf16_t*)(a.ws + WS_HG);
    bf16_t* OA = dmy ? (bf16_t*)(a.ws + WS_DUMMY) - (size_t)(b * SEQ + p * 1024) * DM : (bf16_t*)a.out;
    float* US = (float*)(a.ws + WS_US); float* DT = (float*)(a.ws + WS_DT);
    float lb = 0.f;
    if (l == 1) { const float l0 = a.in[6][h * 128 + ch], l1 = a.in[6][DM + h * 128 + ch]; lb = 1.f / (1.f + expf(l0 - l1)); }
    const float oml = 1.f - lb;
    LAS float* TOT = (LAS float*)(lds + HG_TOT); LAS float* DV = (LAS float*)(lds + HG_DV); LAS float* SSQP = (LAS float*)(lds + HG_SSQP); LAS float* EM = (LAS float*)(lds + HG_EM);
    const int ti = wid & 3, dvh = wid >> 2;
    f32x4 sacc[8];
#pragma unroll
    for (int j = 0; j < 8; ++j) sacc[j] = (f32x4){0.f, 0.f, 0.f, 0.f};
    float gsum = 0.f;
    if (FULL) {
        for (int pp = 0; pp < p; ++pp) {
            const int it2 = item - p + pp;
            const f32x4 dd = *(const f32x4*)(DT + (size_t)it2 * 128 + wid * 16 + 4 * fq);
#pragma unroll
            for (int j = 0; j < 8; ++j)
                { const f32x4 uv = *(const f32x4*)(US + ((((size_t)it2 * 8 + wid) * 8 + j) * 64 + lane) * 4); sacc[j] = sacc[j] * dd + uv; }
        }
    }
    const unsigned gcol = (unsigned)(h * 128 + ch);
    unsigned cHF[8], cHI[8], cHQ[8];
#define HG_LOAD(dstF, dstI, dstQ, cc) do { const size_t r0_ = (row_base + (size_t)(cc) * 64 + seg * 16) * DM; \
        _Pragma("unroll") for (int i_ = 0; i_ < 8; ++i_) { const bf16_t* bF_ = HF + r0_ + (size_t)(2 * i_) * DM; const bf16_t* bI_ = HI + r0_ + (size_t)(2 * i_) * DM; const bf16_t* bQ_ = HQ + r0_ + (size_t)(2 * i_) * DM; \
            dstF[i_] = (unsigned)bF_[gcol] | ((unsigned)bF_[gcol + DM] << 16); \
            dstI[i_] = (unsigned)bI_[gcol] | ((unsigned)bI_[gcol + DM] << 16); \
            if (FULL) dstQ[i_] = (unsigned)bQ_[gcol] | ((unsigned)bQ_[gcol + DM] << 16); } \
        } while (0)
    HG_LOAD(cHF, cHI, cHQ, 0);
    for (int c = 0; c < 16; ++c) {
        unsigned nHF[8], nHI[8], nHQ[8];
        { const int cn = c < 15 ? c + 1 : 15; HG_LOAD(nHF, nHI, nHQ, cn); }
        float cum[16], kk[16];
        {
            float run = 0.f;
#pragma unroll
            for (int i = 0; i < 16; ++i) {
                const float x = (i & 1) ? bfhi(cHF[i >> 1]) : bflo(cHF[i >> 1]);
                const float e = __expf(-x); const float sg = fast_rcp(1.f + e);
                const float f = lb + oml * sg;
                kk[i] = oml * (1.f - sg);
                run += __logf(f); cum[i] = run;
            }
            TOT[seg * 128 + ch] = run;
        }
        __syncthreads();
        float prefix = 0.f; const float t0 = TOT[ch], t1 = TOT[128 + ch], t2 = TOT[256 + ch], t3 = TOT[384 + ch];
        if (seg >= 1) prefix += t0; if (seg >= 2) prefix += t1; if (seg >= 3) prefix += t2;
        const float gmid = t0 + t1, glast = (t0 + t1) + (t2 + t3);
        if (seg == 0) { DV[ch] = __expf(glast); gsum += glast; if (FULL) EM[ch] = __expf(gmid); }
        {
            unsigned kt[8];
            if (FULL) {
                const float El = __expf(glast - gmid);
#pragma unroll
                for (int i = 0; i < 16; i += 2) {
                    const float d0 = fmaxf(prefix + cum[i] - gmid, -80.f), d1 = fmaxf(prefix + cum[i + 1] - gmid, -80.f);
                    const float E0 = __expf(d0), E1 = __expf(d1), R0 = fast_rcp(E0), R1 = fast_rcp(E1);
                    const float kh0 = kk[i] * R0, kh1 = kk[i + 1] * R1;
                    kt[i >> 1] = pk2(kh0 * El, kh1 * El);
                    const unsigned qh = pk2(bflo(cHQ[i >> 1]) * E0, bfhi(cHQ[i >> 1]) * E1), kh = pk2(kh0, kh1);
                    const int tA = seg * 16 + i;
                    *(LAS bf16_t*)(lds + HG_QH + (tA * 136 + ch) * 2) = (bf16_t)(qh & 0xffffu);
                    *(LAS bf16_t*)(lds + HG_QH + ((tA + 1) * 136 + ch) * 2) = (bf16_t)(qh >> 16);
                    *(LAS bf16_t*)(lds + HG_KH + (tA * 136 + ch) * 2) = (bf16_t)(kh & 0xffffu);
                    *(LAS bf16_t*)(lds + HG_KH + ((tA + 1) * 136 + ch) * 2) = (bf16_t)(kh >> 16);
                }
            } else {
#pragma unroll
                for (int i = 0; i < 16; i += 2) kt[i >> 1] = pk2(kk[i] * __expf(glast - (prefix + cum[i])), kk[i + 1] * __expf(glast - (prefix + cum[i + 1])));
            }
            LAS u32x4* kp = (LAS u32x4*)(lds + HG_KTT + (ch * 72 + seg * 16) * 2); LAS u32x4* vp = (LAS u32x4*)(lds + HG_VTT + (ch * 72 + seg * 16) * 2);
            kp[0] = (u32x4){kt[0], kt[1], kt[2], kt[3]}; kp[1] = (u32x4){kt[4], kt[5], kt[6], kt[7]};
            vp[0] = (u32x4){cHI[0], cHI[1], cHI[2], cHI[3]}; vp[1] = (u32x4){cHI[4], cHI[5], cHI[6], cHI[7]};
        }
        __syncthreads();
        f32x4 oacc[4]; f32x4 gn[4]; u32x2 cHG[4];
        if (FULL) {
            {
                const f32x4 em = *(const LAS f32x4*)(lds + HG_EM + (wid * 16 + 4 * fq) * 4);
#pragma unroll
                for (int j = 0; j < 8; ++j) { u32x2 w; w.x = pk2(sacc[j][0] * em[0], sacc[j][1] * em[1]); w.y = pk2(sacc[j][2] * em[2], sacc[j][3] * em[3]); *(LAS u32x2*)(lds + HG_ST + ((j * 16 + fr) * 136 + wid * 16 + 4 * fq) * 2) = w; }
            }
            {
                const int tiA = wid >> 1;
#pragma unroll
                for (int q = 0; q < 2; ++q) {
                    const int sj = (wid & 1) * 2 + q;
                    f32x4 ac = (f32x4){0.f, 0.f, 0.f, 0.f};
#pragma unroll
                    for (int k4 = 0; k4 < 4; ++k4) {
                        const bf16x8 av = lds_ld16(lds + HG_QH + ((tiA * 16 + fr) * 136 + k4 * 32 + 8 * fq) * 2);
                        const bf16x8 bv = lds_ld16(lds + HG_KH + ((sj * 16 + fr) * 136 + k4 * 32 + 8 * fq) * 2);
                        ac = mfma16(av, bv, ac);
                    }
                    const int s = sj * 16 + fr, tb0 = tiA * 16 + 4 * fq;
                    const unsigned w0 = pk2(s <= tb0 ? ac[0] : 0.f, s <= tb0 + 1 ? ac[1] : 0.f), w1 = pk2(s <= tb0 + 2 ? ac[2] : 0.f, s <= tb0 + 3 ? ac[3] : 0.f);
                    *(LAS bf16_t*)(lds + HG_AM + ((tb0 + 0) * 72 + s) * 2) = (bf16_t)(w0 & 0xffffu);
                    *(LAS bf16_t*)(lds + HG_AM + ((tb0 + 1) * 72 + s) * 2) = (bf16_t)(w0 >> 16);
                    *(LAS bf16_t*)(lds + HG_AM + ((tb0 + 2) * 72 + s) * 2) = (bf16_t)(w1 & 0xffffu);
                    *(LAS bf16_t*)(lds + HG_AM + ((tb0 + 3) * 72 + s) * 2) = (bf16_t)(w1 >> 16);
                }
            }
            __syncthreads();
            { const size_t or_ = row_base + (size_t)c * 64 + ti * 16 + fr;
#pragma unroll
              for (int jj = 0; jj < 4; ++jj) { cHG[jj] = *(const u32x2*)(HGt + or_ * DM + h * 128 + (dvh * 4 + jj) * 16 + 4 * fq); gn[jj] = *(const f32x4*)(a.in[7] + l * DM + h * 128 + (dvh * 4 + jj) * 16 + 4 * fq); } }
#pragma unroll
            for (int jj = 0; jj < 4; ++jj) oacc[jj] = (f32x4){0.f, 0.f, 0.f, 0.f};
#pragma unroll
            for (int k2 = 0; k2 < 2; ++k2) {
                const bf16x8 bv = lds_ld16(lds + HG_AM + ((ti * 16 + fr) * 72 + k2 * 32 + 8 * fq) * 2);
#pragma unroll
                for (int jj = 0; jj < 4; ++jj) { const bf16x8 av = lds_ld16(lds + HG_VTT + (((dvh * 4 + jj) * 16 + fr) * 72 + k2 * 32 + 8 * fq) * 2); oacc[jj] = mfma16(av, bv, oacc[jj]); }
            }
#pragma unroll
            for (int k4 = 0; k4 < 4; ++k4) {
                const bf16x8 bv = lds_ld16(lds + HG_QH + ((ti * 16 + fr) * 136 + k4 * 32 + 8 * fq) * 2);
#pragma unroll
                for (int jj = 0; jj < 4; ++jj) { const bf16x8 av = lds_ld16(lds + HG_ST + (((dvh * 4 + jj) * 16 + fr) * 136 + k4 * 32 + 8 * fq) * 2); oacc[jj] = mfma16(av, bv, oacc[jj]); }
            }
            float s = 0.f;
#pragma unroll
            for (int jj = 0; jj < 4; ++jj) s += (oacc[jj][0] * oacc[jj][0] + oacc[jj][1] * oacc[jj][1]) + (oacc[jj][2] * oacc[jj][2] + oacc[jj][3] * oacc[jj][3]);
            s += shx(s, LANE_, 16); s += shx(s, LANE_, 32);
            if (fq == 0) SSQP[dvh * 64 + ti * 16 + fr] = s;
        }
        {
            const f32x4 dd = *(const LAS f32x4*)(lds + HG_DV + (wid * 16 + 4 * fq) * 4);
#pragma unroll
            for (int j = 0; j < 8; ++j) sacc[j] = sacc[j] * dd;
#pragma unroll
            for (int k2 = 0; k2 < 2; ++k2) {
                const bf16x8 av = lds_ld16(lds + HG_KTT + ((wid * 16 + fr) * 72 + k2 * 32 + 8 * fq) * 2);
#pragma unroll
                for (int j = 0; j < 8; ++j) { const bf16x8 bv = lds_ld16(lds + HG_VTT + ((j * 16 + fr) * 72 + k2 * 32 + 8 * fq) * 2); sacc[j] = mfma16(av, bv, sacc[j]); }
            }
        }
        __syncthreads();
        if (FULL) {
            const int t = ti * 16 + fr;
            const float tot = SSQP[t] + SSQP[64 + t];
            const float rs = rsqrtf(tot * (1.f / 128.f) + EPS);
            const size_t orow = row_base + (size_t)c * 64 + t;
#pragma unroll
            for (int jj = 0; jj < 4; ++jj) {
                const int dv0 = (dvh * 4 + jj) * 16 + 4 * fq;
                const u32x2 hg = cHG[jj];
                const float o0 = oacc[jj][0] * rs * gn[jj][0] * bflo(hg.x), o1 = oacc[jj][1] * rs * gn[jj][1] * bfhi(hg.x), o2 = oacc[jj][2] * rs * gn[jj][2] * bflo(hg.y), o3 = oacc[jj][3] * rs * gn[jj][3] * bfhi(hg.y);
                u32x2 w; w.x = pk2(o0, o1); w.y = pk2(o2, o3);
                *(u32x2*)(OA + orow * DM + h * 128 + dv0) = w;
            }
        }
#pragma unroll
        for (int i = 0; i < 8; ++i) { cHF[i] = nHF[i]; cHI[i] = nHI[i]; if (FULL) cHQ[i] = nHQ[i]; }
    }
#undef HG_LOAD
    if (!FULL) {
#pragma unroll
        for (int j = 0; j < 8; ++j)
            *(f32x4*)(US + ((((size_t)item * 8 + wid) * 8 + j) * 64 + lane) * 4) = sacc[j];
        if (seg == 0) DT[(size_t)item * 128 + ch] = __expf(gsum);
    }
    __syncthreads();
}

constexpr int AT_K = 0, AT_V = 69632;
struct AttnIt { int b, g, hh, r, n, d, head; size_t tb; };
__device__ __forceinline__ AttnIt attn_decode(int item) {
    AttnIt t; const int blk = item & 63; t.hh = (item >> 6) & 3; const int gb = item >> 8; t.g = gb % 3; t.b = gb / 3;
    const int dsh = 2 * t.g; t.d = 1 << dsh; const int nb = 64 >> dsh; t.r = blk / nb; t.n = blk % nb; t.head = t.g * 4 + t.hh; t.tb = (size_t)t.b * SEQ + t.r; return t;
}
__device__ __forceinline__ void attn_phase(int wv, const Args& a, LAS unsigned char* lds, int w, bool dmy) {
    const int tid = opaque_tid(wv), lane = tid & 63, wid = __builtin_amdgcn_readfirstlane(tid >> 6), fr = lane & 15, fq = lane >> 4;
    bf16_t* AQ = (bf16_t*)(a.ws + WS_AQ); const bf16_t* AK = (const bf16_t*)(a.ws + WS_AK); const bf16_t* AV = (const bf16_t*)(a.ws + WS_AV);
    const float* HS = (const float*)(a.ws + WS_HSSQ); float* LSE = (float*)(a.ws + WS_LSE);
    const int krow = tid >> 4, kc = tid & 15;
    const int vc = tid >> 6, vrow = (tid & 63) * 2;
    const int qi = 16 * wid + fr;
    u32x4 kr[4], vr[4]; float rk[4]; bf16x8 qf[4]; float qs;
#define AT_LOADBLK(T, blkn) do { _Pragma("unroll") for (int i_ = 0; i_ < 4; ++i_) { \
        const size_t tokk_ = (T).tb + (size_t)(128 * (blkn) + krow + 32 * i_) * (T).d; kr[i_] = *(const u32x4*)(AK + tokk_ * ATW + (T).head * 128 + 8 * kc); rk[i_] = HS[tokk_ * 24 + 12 + (T).head]; \
        const size_t tokv_ = (T).tb + (size_t)(128 * (blkn) + vrow + (i_ & 1)) * (T).d; vr[i_] = *(const u32x4*)(AV + tokv_ * ATW + (T).head * 128 + 8 * (vc + 8 * (i_ >> 1))); } } while (0)
#define AT_LOADQ(T) do { const size_t tq_ = (T).tb + (size_t)(128 * (T).n + qi) * (T).d; \
        _Pragma("unroll") for (int k4_ = 0; k4_ < 4; ++k4_) qf[k4_] = *(const bf16x8*)(AQ + tq_ * ATW + (T).head * 128 + k4_ * 32 + 8 * fq); qs = HS[tq_ * 24 + (T).head]; } while (0)
#define AT_WRITEBLK(slot) do { _Pragma("unroll") for (int i_ = 0; i_ < 4; ++i_) { \
        const float rk_ = rsqrtf(rk[i_] * (1.f / 128.f) + EPS); const u32x4 v_ = kr[i_]; u32x4 w_; \
        w_.x = pk2(bflo(v_.x) * rk_, bfhi(v_.x) * rk_); w_.y = pk2(bflo(v_.y) * rk_, bfhi(v_.y) * rk_); w_.z = pk2(bflo(v_.z) * rk_, bfhi(v_.z) * rk_); w_.w = pk2(bflo(v_.w) * rk_, bfhi(v_.w) * rk_); \
        *(LAS u32x4*)(lds + AT_K + (((slot) * 128 + krow + 32 * i_) * 136 + 8 * kc) * 2) = w_; \
        } \
        _Pragma("unroll") for (int i_ = 0; i_ < 2; ++i_) { const u32x4 e_ = vr[2 * i_], o_ = vr[2 * i_ + 1]; \
        LAS unsigned* vp_ = (LAS unsigned*)(lds + AT_V + ((8 * (vc + 8 * i_)) * 264 + (slot) * 128 + vrow) * 2); \
        vp_[0 * 132] = (e_.x & 0xffffu) | (o_.x << 16); vp_[1 * 132] = (e_.x >> 16) | (o_.x & 0xffff0000u); vp_[2 * 132] = (e_.y & 0xffffu) | (o_.y << 16); vp_[3 * 132] = (e_.y >> 16) | (o_.y & 0xffff0000u); \
        vp_[4 * 132] = (e_.z & 0xffffu) | (o_.z << 16); vp_[5 * 132] = (e_.z >> 16) | (o_.z & 0xffff0000u); vp_[6 * 132] = (e_.w & 0xffffu) | (o_.w << 16); vp_[7 * 132] = (e_.w >> 16) | (o_.w & 0xffff0000u); } } while (0)
    AttnIt T = attn_decode(12 * w);
    if (T.n > 0) { AT_LOADBLK(T, T.n - 1); AT_WRITEBLK((T.n & 1) ^ 1); }
    AT_LOADBLK(T, T.n); AT_LOADQ(T);
    for (int it = 0; it < 12; ++it) {
        const int n = T.n, sl = n & 1, head = T.head;
        if (n == 0) {
            unsigned zz; asm volatile("v_mov_b32 %0, 0" : "=v"(zz)); const u32x4 z = (u32x4){zz, zz, zz, zz};
#pragma unroll
            for (int i = 0; i < 4; ++i) { *(LAS u32x4*)(lds + AT_K + (((sl ^ 1) * 128 + krow + 32 * i) * 136 + 8 * kc) * 2) = z; }
#pragma unroll
            for (int i = 0; i < 4; ++i) { const int id = tid + 512 * i, dvr = id >> 4, c16 = id & 15; *(LAS u32x4*)(lds + AT_V + (dvr * 264 + (sl ^ 1) * 128 + 8 * c16) * 2) = z; }
        }
        AT_WRITEBLK(sl);
        bf16x8 qc[4];
#pragma unroll
        for (int k4 = 0; k4 < 4; ++k4) qc[k4] = qf[k4];
        const float qscale = rsqrtf(qs * (1.f / 128.f) + EPS) * 0.08838834764831845f;
        const size_t tokq = T.tb + (size_t)(128 * n + qi) * T.d;
        __syncthreads();
        if (it < 11) { T = attn_decode(12 * w + it + 1);
            AT_LOADBLK(T, T.n); AT_LOADQ(T); }
        const int px = (sl ^ 1) << 3;
        const int lo2 = (wid & ~1) < 6 ? (wid & ~1) : 6;
        f32x4 sT[10];
        float mx = -INFINITY;
#pragma unroll
        for (int i = 0; i < 10; ++i) {
            const int kt = lo2 + i, pkt = kt ^ px;
            f32x4 ac = (f32x4){0.f, 0.f, 0.f, 0.f};
#pragma unroll
            for (int k4 = 0; k4 < 4; ++k4) ac = mfma16(lds_ld16(lds + AT_K + ((pkt * 16 + fr) * 136 + k4 * 32 + 8 * fq) * 2), qc[k4], ac);
#pragma unroll
            for (int rr = 0; rr < 4; ++rr) {
                const int ki = kt * 16 + 4 * fq + rr;
                const bool valid = (ki >= qi) && (ki <= qi + 128) && (n > 0 || ki >= 128);
                const float sv = valid ? ac[rr] * qscale : -INFINITY;
                ac[rr] = sv; mx = fmaxf(mx, sv);
            }
            sT[i] = ac;
        }
        mx = fmaxf(mx, shx(mx, LANE_, 16)); mx = fmaxf(mx, shx(mx, LANE_, 32));
        float sum = 0.f;
#pragma unroll
        for (int i = 0; i < 10; ++i)
#pragma unroll
            for (int rr = 0; rr < 4; ++rr) { const float pv = __expf(sT[i][rr] - mx); sT[i][rr] = pv; sum += pv; }
        sum += shx(sum, LANE_, 16); sum += shx(sum, LANE_, 32);
        f32x4 oacc[8];
#pragma unroll
        for (int j = 0; j < 8; ++j) oacc[j] = (f32x4){0.f, 0.f, 0.f, 0.f};
#pragma unroll
        for (int pp = 0; pp < 5; ++pp) {
            const int pk0 = (lo2 + 2 * pp) ^ px, pk1 = (lo2 + 2 * pp + 1) ^ px;
            u32x4 pw; pw.x = pk2(sT[2 * pp][0], sT[2 * pp][1]); pw.y = pk2(sT[2 * pp][2], sT[2 * pp][3]); pw.z = pk2(sT[2 * pp + 1][0], sT[2 * pp + 1][1]); pw.w = pk2(sT[2 * pp + 1][2], sT[2 * pp + 1][3]);
            const bf16x8 pf = __builtin_bit_cast(bf16x8, pw);
#pragma unroll
            for (int j = 0; j < 8; ++j) {
                const u32x2 v0 = *(const LAS u32x2*)(lds + AT_V + ((j * 16 + fr) * 264 + pk0 * 16 + 4 * fq) * 2);
                const u32x2 v1 = *(const LAS u32x2*)(lds + AT_V + ((j * 16 + fr) * 264 + pk1 * 16 + 4 * fq) * 2);
                const u32x4 vw = (u32x4){v0.x, v0.y, v1.x, v1.y};
                oacc[j] = mfma16(__builtin_bit_cast(bf16x8, vw), pf, oacc[j]);
            }
        }
        const float inv = 1.f / sum;
#pragma unroll
        for (int j = 0; j < 8; ++j) { u32x2 wv; wv.x = pk2(oacc[j][0] * inv, oacc[j][1] * inv); wv.y = pk2(oacc[j][2] * inv, oacc[j][3] * inv);
            *(u32x2*)((dmy ? (bf16_t*)(a.ws + WS_DUMMY) + (size_t)qi * ATW : AQ + tokq * ATW) + head * 128 + j * 16 + 4 * fq) = wv; }
        if (fq == 0) (dmy ? (float*)(a.ws + WS_DUMMY + MiB) + qi * 12 : LSE + tokq * 12)[head] = mx + __logf(sum);
        __syncthreads();
    }
#undef AT_LOADBLK
#undef AT_LOADQ
#undef AT_WRITEBLK
}

__device__ __forceinline__ void attn_merge(int wv, const Args& a) {
    const int gt = blockIdx.x * NTHR + opaque_tid(wv), GT = NWG * NTHR;
    const bf16_t* OG = (const bf16_t*)(a.ws + WS_AQ); const float* LSE = (const float*)(a.ws + WS_LSE); bf16_t* OB = (bf16_t*)(a.ws + WS_OB);
    for (int i = gt; i < MTOK * 64; i += GT) {
        const int tok = i >> 6, hh = (i >> 4) & 3, c = i & 15;
        const float l0 = LSE[(size_t)tok * 12 + hh], l1 = LSE[(size_t)tok * 12 + 4 + hh], l2 = LSE[(size_t)tok * 12 + 8 + hh];
        const float mxl = fmaxf(l0, fmaxf(l1, l2));
        float a0 = __expf(l0 - mxl), a1 = __expf(l1 - mxl), a2 = __expf(l2 - mxl); const float inv = 1.f / (a0 + a1 + a2); a0 *= inv; a1 *= inv; a2 *= inv;
        const u32x4 v0 = *(const u32x4*)(OG + (size_t)tok * ATW + hh * 128 + 8 * c), v1 = *(const u32x4*)(OG + (size_t)tok * ATW + (4 + hh) * 128 + 8 * c), v2 = *(const u32x4*)(OG + (size_t)tok * ATW + (8 + hh) * 128 + 8 * c);
        u32x4 w;
        w.x = pk2(a0 * bflo(v0.x) + a1 * bflo(v1.x) + a2 * bflo(v2.x), a0 * bfhi(v0.x) + a1 * bfhi(v1.x) + a2 * bfhi(v2.x));
        w.y = pk2(a0 * bflo(v0.y) + a1 * bflo(v1.y) + a2 * bflo(v2.y), a0 * bfhi(v0.y) + a1 * bfhi(v1.y) + a2 * bfhi(v2.y));
        w.z = pk2(a0 * bflo(v0.z) + a1 * bflo(v1.z) + a2 * bflo(v2.z), a0 * bfhi(v0.z) + a1 * bfhi(v1.z) + a2 * bfhi(v2.z));
        w.w = pk2(a0 * bflo(v0.w) + a1 * bflo(v1.w) + a2 * bflo(v2.w), a0 * bfhi(v0.w) + a1 * bfhi(v1.w) + a2 * bfhi(v2.w));
        *(u32x4*)(OB + (size_t)tok * 512 + hh * 128 + 8 * c) = w;
    }
}


#define XB_TMO      128
#define XB_XCNT(j)  (256  + 64 * (j))
#define XB_XSUB(j)  (1280 + 64 * (j))
#define XB_XGEN(j)  (2304 + 64 * (j))
#define XB_TOP      3328
#define XB_TOPGEN   3392
#define XCD_BAR_WORDS 3456
#define XB_SPIN_CAP (1u << 18)
__device__ __forceinline__ unsigned xb_ld(unsigned* p)              { return __hip_atomic_load(p, __ATOMIC_RELAXED, __HIP_MEMORY_SCOPE_AGENT); }
__device__ __forceinline__ unsigned xb_add(unsigned* p, unsigned v) { return __hip_atomic_fetch_add(p, v, __ATOMIC_RELAXED, __HIP_MEMORY_SCOPE_AGENT); }
__device__ __forceinline__ unsigned xb_xcc_id() { return (unsigned)__builtin_amdgcn_s_getreg((3 << 11) | 20) & 0xFu; }
#define XB_SPIN(cond, bar) do { unsigned _sp = 0; while (cond) { __builtin_amdgcn_s_sleep(1); \
    if ((++_sp & 255u) == 0u) { if (xb_ld(&(bar)[XB_TMO])) break; if (_sp > XB_SPIN_CAP) { atomicAdd(&(bar)[XB_TMO], 1u); break; } } } } while (0)
struct XcdBarrier { unsigned* bar; unsigned x; volatile LAS unsigned* st; };
__device__ __forceinline__ XcdBarrier xcd_barrier_post(unsigned* bar, volatile LAS unsigned* st, bool t0) {
    XcdBarrier b; b.bar = bar; b.x = xb_xcc_id(); b.st = st;
    if (t0) (void)xb_add(&bar[XB_XCNT(b.x)], 1u);
    return b;
}
__device__ __forceinline__ void xcd_barrier_complete(unsigned* bar, unsigned x, unsigned& nloc, unsigned& nx) {
    const unsigned G = gridDim.x * gridDim.y * gridDim.z;
    unsigned sum, cnt, mine, sp = 0u;
    for (;;) {
        sum = 0u; cnt = 0u; mine = 0u;
#pragma unroll
        for (unsigned j = 0; j < 16; ++j) { const unsigned c = xb_ld(&bar[XB_XCNT(j)]); sum += c; cnt += (c > 0u) ? 1u : 0u; mine = (j == x) ? c : mine; }
        if (sum == G) break;
        __builtin_amdgcn_s_sleep(1);
        if ((++sp & 255u) == 0u) { if (xb_ld(&bar[XB_TMO])) break; if (sp > XB_SPIN_CAP) { atomicAdd(&bar[XB_TMO], 1u); break; } }
    }
    nloc = mine > 0u ? mine : 1u; nx = cnt > 0u ? cnt : 1u;
}
__device__ __forceinline__ void xcd_barrier(const XcdBarrier& b, bool t0) {
    asm volatile("s_waitcnt vmcnt(0)" ::: "memory");
    __syncthreads();
    if (t0) {
        unsigned* bar = b.bar;
        __builtin_amdgcn_s_waitcnt(0);
        unsigned nloc = b.st[0], nx = b.st[1];
        if (nloc == 0u) { xcd_barrier_complete(bar, b.x, nloc, nx); b.st[0] = nloc; b.st[1] = nx; }
        const unsigned old = xb_add(&bar[XB_XSUB(b.x)], 1u);
        const unsigned gen = old / nloc;
        if (old + 1u == (gen + 1u) * nloc) {
            __builtin_amdgcn_fence(__ATOMIC_RELEASE, "agent");
            asm volatile("s_waitcnt vmcnt(0)" ::: "memory");
            const unsigned og = xb_add(&bar[XB_TOP], 1u);
            const unsigned tg = og / nx;
            if (og + 1u == (tg + 1u) * nx) xb_add(&bar[XB_TOPGEN], 1u);
            else XB_SPIN(xb_ld(&bar[XB_TOPGEN]) == tg, bar);
            __builtin_amdgcn_fence(__ATOMIC_ACQUIRE, "agent");
            xb_add(&bar[XB_XGEN(b.x)], 1u);
            asm volatile("s_waitcnt vmcnt(0)" ::: "memory");
        } else {
            XB_SPIN(xb_ld(&bar[XB_XGEN(b.x)]) == gen, bar);
            __builtin_amdgcn_fence(__ATOMIC_ACQUIRE, "agent");
            asm volatile("s_waitcnt vmcnt(0)" ::: "memory");
        }
    }
    __syncthreads();
}

typedef const __attribute__((address_space(4))) Args* ArgsCP;
__device__ __forceinline__ Args load_args(ArgsCP p) { asm volatile("" : "+s"(p)); Args a;
#pragma unroll
    for (int i = 0; i < 16; ++i) a.in[i] = p->in[i];
    a.out = p->out; a.ws = p->ws; return a; }
__global__ void __launch_bounds__(NTHR, 2) fwd_kernel(Args a_unused) {
    extern __shared__ __attribute__((aligned(16))) unsigned char lds_raw[];
    LAS unsigned char* lds = (LAS unsigned char*)lds_raw;
    cg::grid_group grid = cg::this_grid();
    const int G = NWG, bid = blockIdx.x;
    const int wv = __builtin_amdgcn_readfirstlane(threadIdx.x >> 6);
    ArgsCP ap = (ArgsCP)__builtin_amdgcn_kernarg_segment_ptr();
#define GSYNC() do { XcdBarrier xb_; xb_.bar = (unsigned*)load_args(ap).ws; xb_.x = xb_xcc_id(); xb_.st = (volatile LAS unsigned*)(lds + LDS_BYTES - 16); xcd_barrier(xb_, opaque_tid(wv) == 0); } while (0)
#ifndef PH_MASK
#define PH_MASK 0xffff
#endif
#define PH(b) if constexpr ((PH_MASK >> (b)) & 1)
#ifndef DUP_MASK
#define DUP_MASK 0
#endif
#define REP(b) for (int rep_ = ((DUP_MASK >> (b)) & 1) ? 0 : 1; rep_ < 2; ++rep_)
#define DMY (rep_ == 0)
#define LOADARGS const Args a = load_args(ap); unsigned char* ws = a.ws; float* ssq = (float*)(ws + WS_SSQ); bf16_t* XB = (bf16_t*)(ws + WS_XB); bf16_t* HID = (bf16_t*)(ws + WS_HID); \
    const float* ssq0 = ssq + (size_t)(3 * l) * MTOK; float* ssq1 = ssq + (size_t)(3 * l + 1) * MTOK; float* ssq2 = ssq + (size_t)(3 * l + 2) * MTOK; float* ssq3 = ssq + (size_t)(3 * l + 3) * MTOK; \
    (void)ssq0; (void)ssq1; (void)ssq2; (void)ssq3; (void)XB; (void)HID;

    volatile LAS unsigned* xst = (volatile LAS unsigned*)(lds + LDS_BYTES - 16);
    { const int t_ = opaque_tid(wv); if (t_ < 4) xst[t_] = 0u; }
    if (load_args(ap).ws == nullptr) grid.sync();
    (void)xcd_barrier_post((unsigned*)load_args(ap).ws, xst, opaque_tid(wv) == 0);
    PH(0) { const int l = 0; LOADARGS; prologue_x(wv, a); }
    for (int l = 0; l < 2; ++l) {
        PH(1) REP(1) { LOADARGS; convert_weights(wv, a, l, lds);
            float* hs = (float*)(ws + WS_HSSQ);
            for (int i = bid * NTHR + opaque_tid(wv); i < MTOK * 24; i += NWG * NTHR) hs[i] = 0.f; }
        GSYNC();
        PH(2) REP(2) { LOADARGS; pg8::Gemm g{XB, (const bf16_t*)(ws + W_1T), MTOK, 2 * DFF, DM}; pg8::StaticOrder S; S.init(MTOK, 2 * DFF, G, bid); EpiFfnIn E{HID, ssq0}; pg8::gemm_phase(wv, lds, g, S, E); }
        GSYNC();
        PH(3) REP(3) { LOADARGS; pg8::Gemm g{HID, (const bf16_t*)(ws + W_1O), MTOK, DM, DFF}; pg8::StaticOrder S; S.init(MTOK, DM, G, bid); EpiResid E{a.out, XB, (unsigned char*)(ws + WS_XL), DMY ? (float*)(ws + WS_DUMMY) : ssq1, DMY ? 0.f : 0.5f, false}; pg8::gemm_phase(wv, lds, g, S, E); }
        GSYNC();
        PH(4) REP(4) { LOADARGS; pg8::Gemm g{XB, (const bf16_t*)(ws + W_IN), MTOK, 4096, DM}; pg8::StaticOrder S; S.init(MTOK, 4096, G, bid); EpiProjA E{(bf16_t*)(ws + WS_HQ), ssq1}; pg8::gemm_phase(wv, lds, g, S, E); }
        GSYNC();
        PH(5) REP(5) { LOADARGS; hgrn_pass<false>(wv, a, l, lds, bid, false); }
        GSYNC();
        PH(6) REP(6) { LOADARGS; hgrn_pass<true>(wv, a, l, lds, bid, DMY); }
        GSYNC();
        PH(7) REP(7) { LOADARGS; pg8::Gemm g{XB, (const bf16_t*)(ws + W_IN) + (size_t)4096 * DM, MTOK, 3 * ATW, DM}; pg8::StaticOrder S; S.init(MTOK, 3 * ATW, G, bid);
          EpiProjB E{(bf16_t*)(ws + WS_AQ), ssq1, (float*)(ws + (DMY ? WS_DUMMY : WS_HSSQ)), a.in[8] + l * 384, a.in[9] + l * 384, (const float*)(ws + WS_COS), (const float*)(ws + WS_SIN)}; pg8::gemm_phase(wv, lds, g, S, E); }
        GSYNC();
        PH(8) REP(8) { LOADARGS; attn_phase(wv, a, lds, bid, DMY); }
        GSYNC();
        PH(9) REP(9) { LOADARGS; attn_merge(wv, a); }
        GSYNC();
        PH(10) { pg8::StaticOrder S; S.init(MTOK, DM, G, bid);
          { LOADARGS; pg8::Gemm g{(const bf16_t*)a.out, (const bf16_t*)(ws + W_A), MTOK, DM, DM}; EpiStoreBf16 E{(bf16_t*)(ws + WS_T1)}; pg8::gemm_phase(wv, lds, g, S, E); }
          { LOADARGS; pg8::Gemm g{(const bf16_t*)(ws + WS_OB), (const bf16_t*)(ws + W_B), MTOK, DM, 512}; EpiStoreBf16 E{(bf16_t*)(ws + WS_T2)}; pg8::gemm_phase(wv, lds, g, S, E); }
          { LOADARGS; PairOrder S2; S2.S = S;
            pg8::Gemm g{XB, (const bf16_t*)(ws + W_IN) + (size_t)8704 * DM, MTOK, 2 * DM, DM}; EpiGateMerge E{(bf16_t*)(ws + WS_T1), (const bf16_t*)(ws + WS_T2), ssq1}; pg8::gemm_phase(wv, lds, g, S2, E); }
        }
        GSYNC();
        PH(11) REP(11) { LOADARGS; pg8::Gemm g{(const bf16_t*)(ws + WS_T1), (const bf16_t*)(ws + W_O), MTOK, DM, DM}; pg8::StaticOrder S; S.init(MTOK, DM, G, bid); EpiResid E{a.out, XB, (unsigned char*)(ws + WS_XL), DMY ? (float*)(ws + WS_DUMMY) : ssq2, DMY ? 0.f : 1.0f, false}; pg8::gemm_phase(wv, lds, g, S, E); }
        GSYNC();
        PH(12) REP(12) { LOADARGS; pg8::Gemm g{XB, (const bf16_t*)(ws + W_2T), MTOK, 2 * DFF, DM}; pg8::StaticOrder S; S.init(MTOK, 2 * DFF, G, bid); EpiFfnIn E{HID, ssq2}; pg8::gemm_phase(wv, lds, g, S, E); }
        GSYNC();
        PH(13) REP(13) { LOADARGS; pg8::Gemm g{HID, (const bf16_t*)(ws + W_2O), MTOK, DM, DFF}; pg8::StaticOrder S; S.init(MTOK, DM, G, bid); EpiResid E{a.out, XB, (unsigned char*)(ws + WS_XL), DMY ? (float*)(ws + WS_DUMMY) : ssq3, DMY ? 0.f : 0.5f, l == 1}; pg8::gemm_phase(wv, lds, g, S, E); }
        GSYNC();
    }
}

extern "C" void kernel_launch(void* const* d_in, const int* in_sizes, int n_in, void* d_out, int out_size, void* d_ws, size_t ws_size, hipStream_t stream) {
    static int grid = 0;
    if (grid == 0) {
        int dev = 0, cus = 0, per_cu = 0;
        (void)hipGetDevice(&dev);
        (void)hipDeviceGetAttribute(&cus, hipDeviceAttributeMultiprocessorCount, dev);
        (void)hipFuncSetAttribute((const void*)fwd_kernel, hipFuncAttributeMaxDynamicSharedMemorySize, LDS_BYTES);
        (void)hipOccupancyMaxActiveBlocksPerMultiprocessor(&per_cu, (const void*)fwd_kernel, NTHR, LDS_BYTES);
        if (cus != NWG || per_cu < 1 || n_in != 16 || ws_size < 512 * MiB) fprintf(stderr, "kernel_launch: unexpected config cus %d per_cu %d n_in %d ws %zu\n", cus, per_cu, n_in, ws_size);
        grid = NWG;
    }
    Args a{};
    for (int i = 0; i < 16; ++i) a.in[i] = (const float*)d_in[i];
    a.out = (float*)d_out; a.ws = (unsigned char*)d_ws;
    if (hipMemsetAsync(d_ws, 0, 16384, stream) != hipSuccess) fprintf(stderr, "kernel_launch: memset of the barrier words failed\n");
    void* args[] = {&a};
    hipError_t e = hipLaunchCooperativeKernel((const void*)fwd_kernel, dim3(grid), dim3(NTHR), args, LDS_BYTES, stream);
    if (e != hipSuccess) fprintf(stderr, "cooperative launch failed: %s\n", hipGetErrorString(e));
}
```

```cpp
#include <hip/hip_runtime.h>
#include <hip/hip_cooperative_groups.h>
#include <cstdio>
#include <cstdint>
namespace cg = cooperative_groups;

#define LAS __attribute__((address_space(3)))
typedef unsigned short bf16_t;
typedef short bf16x8 __attribute__((ext_vector_type(8)));
typedef short s16x4 __attribute__((ext_vector_type(4)));
typedef float f32x4 __attribute__((ext_vector_type(4)));
typedef float f32x2 __attribute__((ext_vector_type(2)));
typedef unsigned u32x4 __attribute__((ext_vector_type(4)));
typedef unsigned u32x2 __attribute__((ext_vector_type(2)));
typedef __bf16 bf2_t __attribute__((ext_vector_type(2)));

constexpr int BATCH = 4, SEQ = 8192, DM = 1024, MTOK = BATCH * SEQ, DFF = 2816, PIN = 10752;
constexpr int ATW = 1536;
constexpr float EPS = 1e-6f;
constexpr int NWG = 256, NTHR = 512;
constexpr int LDS_BYTES = 147456;

constexpr size_t MiB = 1u << 20;
constexpr size_t WS_SSQ = 1 * MiB;
constexpr size_t WS_COS = 2 * MiB, WS_SIN = 4 * MiB;
constexpr size_t WS_W = 6 * MiB;
constexpr size_t W_1T = WS_W, W_1O = W_1T + 11 * MiB, W_IN = W_1O + 11 * MiB / 2, W_A = W_IN + 21 * MiB, W_B = W_A + 2 * MiB, W_O = W_B + 1 * MiB,
                 W_2T = W_O + 2 * MiB, W_2O = W_2T + 11 * MiB;
constexpr size_t WS_XB = 65 * MiB;
constexpr size_t WS_XL = 129 * MiB;
constexpr size_t WS_R = 193 * MiB;
constexpr size_t WS_HID = WS_R;
constexpr size_t WS_HQ = WS_R, WS_HF = WS_R + 64 * MiB, WS_HI = WS_R + 128 * MiB, WS_HG = WS_R + 192 * MiB;
constexpr size_t WS_US = WS_R + 256 * MiB;
constexpr size_t WS_DT = WS_US + 16 * MiB;
constexpr size_t WS_AQ = WS_R, WS_AK = WS_AQ + 96 * MiB, WS_AV = WS_AK + 96 * MiB;
constexpr size_t WS_HSSQ = 481 * MiB;
constexpr size_t WS_LSE = 485 * MiB;
constexpr size_t WS_DUMMY = 487 * MiB;
constexpr size_t WS_OB = WS_AK;
constexpr size_t WS_T1 = WS_AV;
constexpr size_t WS_T2 = WS_AQ;
static_assert(W_2O + 11 * MiB / 2 <= WS_XB, "weights");
static_assert(WS_DT + 256 * 128 * 4 <= 481 * MiB && WS_AV + 96 * MiB == 481 * MiB && WS_HID + (size_t)MTOK * DFF * 2 <= 481 * MiB, "ws");

__device__ __forceinline__ float bf2f(bf16_t v) { return __uint_as_float(((unsigned)v) << 16); }
__device__ __forceinline__ float bflo(unsigned u) { return __uint_as_float(u << 16); }
__device__ __forceinline__ float bfhi(unsigned u) { return __uint_as_float(u & 0xffff0000u); }
__device__ __forceinline__ unsigned pk2(float lo, float hi) { f32x2 v = {lo, hi}; bf2_t b = __builtin_convertvector(v, bf2_t); return __builtin_bit_cast(unsigned, b); }
__device__ __forceinline__ bf16_t f2bf(float f) { return (bf16_t)(pk2(f, 0.f) & 0xffffu); }
__device__ __forceinline__ float fast_rcp(float x) { return __builtin_amdgcn_rcpf(x); }
__device__ __forceinline__ float sigmoidf_(float x) { return fast_rcp(1.f + __expf(-x)); }
__device__ __forceinline__ float siluf_(float x) { return x * sigmoidf_(x); }
__device__ __forceinline__ int opaque_tid(int wv) { int l; asm volatile("v_mbcnt_lo_u32_b32 %0, -1, 0\n\tv_mbcnt_hi_u32_b32 %0, -1, %0" : "=v"(l)); return (wv << 6) | l; }
template <class Tp> __device__ __forceinline__ Tp* opaque_ptr(Tp* p) { asm volatile("" : "+s"(p)); return p; }
__device__ __forceinline__ float shx(float v, int lane, int mask) { return __int_as_float(__builtin_amdgcn_ds_bpermute((lane ^ mask) << 2, __float_as_int(v))); }
__device__ __forceinline__ bf16x8 lds_ld16(LAS unsigned char* p) { return *(const LAS bf16x8*)p; }
__device__ __forceinline__ f32x4 mfma16(bf16x8 a, bf16x8 b, f32x4 c) { return __builtin_amdgcn_mfma_f32_16x16x32_bf16(a, b, c, 0, 0, 0); }

namespace pg8 {
constexpr int BM = 256, BK = 64, HALF = 128, HTB = HALF * BK * 2, STAGE_BYTES = 8 * HTB, NXCD = 8, WGM = 8;
__host__ __device__ __forceinline__ int lds_byte(int r, int c) { const int st = (r >> 4) * 2 + (c >> 5), rr = r & 15, cc = c & 31, ob = rr * 64 + cc * 2; return st * 1024 + (ob ^ (((ob >> 9) & 1) << 5)); }
__host__ __device__ __forceinline__ void stage_rc(int b, int& R, int& C) { const int st = b / 1024, sb = b % 1024, swz = sb ^ (((sb >> 9) & 1) << 5); R = (st >> 1) * 16 + swz / 64; C = (st & 1) * 32 + (swz % 64) / 2; }
__host__ __device__ __forceinline__ int perm32(int rho) { const int n = rho >> 4, i = rho & 15; return 8 * (i >> 2) + 4 * n + (i & 3); }
__host__ __device__ __forceinline__ int permB_std(int R) { return (R & ~31) + perm32(R & 31); }
__host__ __device__ __forceinline__ int permB_rope(int R) { const int wc = R >> 5, n = (R >> 4) & 1, i = R & 15; return 64 * n + 16 * wc + i; }

__host__ __device__ __forceinline__ int permB_wide(int R) { const int j32 = perm32(R & 31); return 64 * (R >> 5) + 16 * (j32 >> 3) + (j32 & 7); }
__host__ __device__ __forceinline__ int permB_rope2(int R) { return 128 * (R >> 6) + 32 * ((R >> 5) & 1) + perm32(R & 31); }
struct Unit { int pm, pn; };
struct Gemm { const bf16_t* A; const bf16_t* Bt; int M, N, K; };
struct StaticOrder {
    int nM, nN, nwg, G, c;
    __device__ void init(int M, int N, int G_, int c_) { nM = M / BM; nN = N / BM; nwg = nM * nN; G = G_; c = c_; }
    __device__ bool next(int i, Unit& u) const {
        const long L = (long)i * G + c; if (L >= nwg) return false;
        int wgid = (int)L; { const int q = nwg / NXCD, r = nwg % NXCD, xcd = wgid % NXCD, off = wgid / NXCD; wgid = (xcd < r ? xcd * (q + 1) : r * (q + 1) + (xcd - r) * q) + off; }
        const int nig = WGM * nN, gid = wgid / nig, fm = gid * WGM, gsz = (nM - fm) < WGM ? (nM - fm) : WGM;
        u.pm = fm + ((wgid % nig) % gsz); u.pn = (wgid % nig) / gsz; return true;
    }
};

template <class Epi, class Sched>
__device__ __forceinline__ void gemm_phase(int wv, LAS unsigned char* lds, const Gemm g, const Sched& S, const Epi& E) {
    const int tid = opaque_tid(wv), wid = __builtin_amdgcn_readfirstlane(tid >> 6), lane = tid & 63, wr = wid >> 2, wc = wid & 3, fr = lane & 15, fq = lane >> 4;
    const int K = g.K, nt = K / BK;
    unsigned voffA[2], voffB[2];
#pragma unroll
    for (int i = 0; i < 2; ++i) { int R, C; stage_rc(tid * 16 + i * 8192, R, C); const int Rb = Epi::permB(R);
        voffA[i] = (unsigned)(R * K + C) * 2u; voffB[i] = (unsigned)(Rb * K + C) * 2u; }
    const size_t kstep = (size_t)(BK * 2);
    const size_t hstep = (size_t)HALF * K * 2;
    const size_t tstep = 2 * hstep;
    const size_t hstepB = (size_t)Epi::BHALF * K * 2;
    const size_t tstepB = (size_t)Epi::BTILE * K * 2;
    const unsigned ldsw = (unsigned)wid * 1024u;
    const int aoff = lds_byte(wr * 64 + fr, fq * 8), boff = lds_byte(wc * 32 + fr, fq * 8);
#define PG8_SA(b, h) (((b) * 2 + (h)) * HTB)
#define PG8_SB(b, h) ((4 + (b) * 2 + (h)) * HTB)
#define PG8_STAGE(bufoff, gbase, voff) do { _Pragma("unroll") for (int _i = 0; _i < 2; ++_i) \
        __builtin_amdgcn_global_load_lds((const unsigned*)((const char*)(gbase) + (voff)[_i]), (LAS unsigned*)(lds + (bufoff) + ldsw + _i * 8192), 16, 0, 0); } while (0)
#define PG8_LDA(dst, b, h) do { _Pragma("unroll") for (int m = 0; m < 4; ++m) _Pragma("unroll") for (int k = 0; k < 2; ++k) dst[m][k] = *(const LAS bf16x8*)(lds + PG8_SA(b, h) + aoff + m * 2048 + k * 1024); } while (0)
#define PG8_LDB(dst, b, h) do { _Pragma("unroll") for (int n = 0; n < 2; ++n) _Pragma("unroll") for (int k = 0; k < 2; ++k) dst[n][k] = *(const LAS bf16x8*)(lds + PG8_SB(b, h) + boff + n * 2048 + k * 1024); } while (0)
#define PG8_MMA(ai, bj, At, Bt) do { __builtin_amdgcn_s_setprio(1); _Pragma("unroll") for (int m = 0; m < 4; ++m) _Pragma("unroll") for (int n = 0; n < 2; ++n) _Pragma("unroll") for (int k = 0; k < 2; ++k) \
        acc[ai][bj][m][n] = __builtin_amdgcn_mfma_f32_16x16x32_bf16(Bt[n][k], At[m][k], acc[ai][bj][m][n], 0, 0, 0); __builtin_amdgcn_s_setprio(0); } while (0)
#define PG8_WAIT_V(n) asm volatile("s_waitcnt vmcnt(" #n ")" ::: "memory")
#define PG8_WAIT_L(n) asm volatile("s_waitcnt lgkmcnt(" #n ")" ::: "memory")
#define PG8_BAR __builtin_amdgcn_s_barrier()
#define PG8_SCHED __builtin_amdgcn_sched_barrier(0)
    Unit cur, nxt; int ui = 0;
    if (!S.next(0, cur)) return;
    f32x4 acc[2][2][4][2];
#pragma unroll
    for (int a = 0; a < 2; ++a)
#pragma unroll
        for (int b = 0; b < 2; ++b)
#pragma unroll
            for (int m = 0; m < 4; ++m)
#pragma unroll
                for (int n = 0; n < 2; ++n) acc[a][b][m][n] = (f32x4){0.f, 0.f, 0.f, 0.f};
    bf16x8 At[4][2], B0[2][2], B1[2][2];
    const char* cA = (const char*)g.A + (size_t)cur.pm * tstep; const char* cB = (const char*)g.Bt + (size_t)cur.pn * tstepB;
    PG8_STAGE(PG8_SB(0, 0), cB, voffB); PG8_STAGE(PG8_SB(0, 1), cB + hstepB, voffB); PG8_STAGE(PG8_SA(0, 0), cA, voffA); PG8_STAGE(PG8_SA(0, 1), cA + hstep, voffA);
    if (wr == 1) PG8_BAR;
    PG8_WAIT_V(2); PG8_BAR;
    PG8_STAGE(PG8_SB(1, 0), cB + kstep, voffB); PG8_STAGE(PG8_SA(1, 0), cA + kstep, voffA); PG8_STAGE(PG8_SB(1, 1), cB + hstepB + kstep, voffB);
    PG8_WAIT_V(6); PG8_BAR;
    for (;;) {
        const bool has_next = S.next(ui + 1, nxt);
        const char* nA = has_next ? (const char*)g.A + (size_t)nxt.pm * tstep : cA; const char* nB = has_next ? (const char*)g.Bt + (size_t)nxt.pn * tstepB : cB;
        for (int t = 0; t < nt; t += 2) {
            const bool last = (t == nt - 2);
            const char* a1 = cA + (size_t)(t + 1) * kstep;
            const char* a2 = last ? nA : cA + (size_t)(t + 2) * kstep; const char* b2 = last ? nB : cB + (size_t)(t + 2) * kstep;
            const char* a3 = a2 + kstep; const char* b3 = b2 + kstep;
            PG8_LDB(B0, 0, 0); PG8_LDB(B1, 0, 1); PG8_SCHED; PG8_LDA(At, 0, 0); PG8_STAGE(PG8_SA(1, 1), a1 + hstep, voffA);
            PG8_WAIT_V(8); PG8_WAIT_L(0); PG8_BAR; PG8_MMA(0, 0, At, B0); PG8_MMA(0, 1, At, B1); PG8_BAR; PG8_SCHED;
            PG8_LDA(At, 0, 1); PG8_STAGE(PG8_SB(0, 0), b2, voffB); PG8_STAGE(PG8_SB(0, 1), b2 + hstepB, voffB); PG8_STAGE(PG8_SA(0, 0), a2, voffA);
            PG8_WAIT_V(8); PG8_WAIT_L(0); PG8_BAR; PG8_MMA(1, 0, At, B0); PG8_MMA(1, 1, At, B1); PG8_BAR; PG8_SCHED;
            PG8_LDB(B0, 1, 0); PG8_LDB(B1, 1, 1); PG8_SCHED; PG8_LDA(At, 1, 0); PG8_STAGE(PG8_SA(0, 1), a2 + hstep, voffA);
            PG8_WAIT_V(8); PG8_WAIT_L(0); PG8_BAR; PG8_MMA(0, 0, At, B0); PG8_MMA(0, 1, At, B1); PG8_BAR; PG8_SCHED;
            PG8_LDA(At, 1, 1); PG8_STAGE(PG8_SB(1, 0), b3, voffB); PG8_STAGE(PG8_SB(1, 1), b3 + hstepB, voffB); PG8_STAGE(PG8_SA(1, 0), a3, voffA);
            PG8_WAIT_V(8); PG8_WAIT_L(0); PG8_BAR; PG8_MMA(1, 0, At, B0); PG8_MMA(1, 1, At, B1); PG8_BAR; PG8_SCHED;
        }
        if (wr == 0) PG8_BAR;
        E(acc, cur, wr, wc, fr, fq);
        if (!has_next) break;
#pragma unroll
        for (int a = 0; a < 2; ++a)
#pragma unroll
            for (int b = 0; b < 2; ++b)
#pragma unroll
                for (int m = 0; m < 4; ++m)
#pragma unroll
                    for (int n = 0; n < 2; ++n) acc[a][b][m][n] = (f32x4){0.f, 0.f, 0.f, 0.f};
        cur = nxt; cA = nA; cB = nB; ++ui;
        if (wr == 1) PG8_BAR;
    }
    PG8_WAIT_V(0);
    PG8_BAR;
#undef PG8_SA
#undef PG8_SB
#undef PG8_STAGE
#undef PG8_LDA
#undef PG8_LDB
#undef PG8_MMA
#undef PG8_WAIT_V
#undef PG8_WAIT_L
#undef PG8_BAR
#undef PG8_SCHED
}
}
struct PairOrder { pg8::StaticOrder S; __device__ bool next(int i, pg8::Unit& u) const { if (!S.next(i >> 1, u)) return false; u.pn = 2 * u.pn + (i & 1); return true; } };
using pg8::Unit;
typedef f32x4 AccT[2][2][4][2];

__device__ __forceinline__ float rstd_row(const float* ssq, int row) { return rsqrtf(ssq[row] * (1.f / 1024.f) + EPS); }

struct EpiFfnIn {
    static constexpr int BHALF = 128, BTILE = 256;
    static __device__ __forceinline__ int permB(int R) { return pg8::permB_std(R); }
    bf16_t* H; const float* ssq;
    __device__ __forceinline__ void operator()(const AccT& acc, const Unit& u, int wr, int wc, int fr, int fq) const {
        const int row0 = u.pm * 256 + wr * 64 + fr, col0 = u.pn * 128 + wc * 32 + 8 * fq;
        float rsv[8];
#pragma unroll
        for (int idx = 0; idx < 8; ++idx) rsv[idx] = ssq[row0 + (idx >> 2) * 128 + (idx & 3) * 16];
#pragma unroll
        for (int ai = 0; ai < 2; ++ai)
#pragma unroll
            for (int m = 0; m < 4; ++m) {
                const int row = row0 + ai * 128 + m * 16; const float rs = rsqrtf(rsv[ai * 4 + m] * (1.f / 1024.f) + EPS);
                float h[8];
#pragma unroll
                for (int n = 0; n < 2; ++n)
#pragma unroll
                    for (int j = 0; j < 4; ++j) { const float a = acc[ai][0][m][n][j] * rs, b = acc[ai][1][m][n][j] * rs; h[n * 4 + j] = siluf_(a) * b; }
                u32x4 w; w.x = pk2(h[0], h[1]); w.y = pk2(h[2], h[3]); w.z = pk2(h[4], h[5]); w.w = pk2(h[6], h[7]);
                *(u32x4*)(H + (size_t)row * DFF + col0) = w;
            }
    }
};

#define EPI_SCHED() __builtin_amdgcn_sched_barrier(0)
#define LANE_ (fq * 16 + fr)
__device__ __forceinline__ unsigned pk_lo8(float a, float b, float c, float d) { int w = 0; w = __builtin_amdgcn_cvt_pk_fp8_f32(a * 512.f, b * 512.f, w, false); w = __builtin_amdgcn_cvt_pk_fp8_f32(c * 512.f, d * 512.f, w, true); return (unsigned)w; }
__device__ __forceinline__ f32x4 un_lo8(unsigned w) { return (f32x4){__builtin_amdgcn_cvt_f32_fp8((int)w, 0), __builtin_amdgcn_cvt_f32_fp8((int)w, 1), __builtin_amdgcn_cvt_f32_fp8((int)w, 2), __builtin_amdgcn_cvt_f32_fp8((int)w, 3)} * (1.f / 512.f); }
struct EpiResid {
    static constexpr int BHALF = 8, BTILE = 256;
    static __device__ __forceinline__ int permB(int R) { return pg8::permB_wide(R); }
    float* OUT; bf16_t* XB; unsigned char* XL; float* ssq_next; float scale; bool last;
    __device__ __forceinline__ void operator()(const AccT& acc, const Unit& u, int wr, int wc, int fr, int fq) const {
        const int row0 = u.pm * 256 + wr * 64 + fr, col0 = u.pn * 256 + wc * 64 + 16 * fq;
        const size_t off0 = (size_t)row0 * DM + col0;
        u32x4 hr[4][2], lr[4];
#pragma unroll
        for (int i = 0; i < 4; ++i) { const size_t o = off0 + (size_t)(i * 16) * DM; hr[i][0] = *(const u32x4*)(XB + o); hr[i][1] = *(const u32x4*)(XB + o + 8); lr[i] = *(const u32x4*)(XL + o); }
        EPI_SCHED();
#pragma unroll
        for (int idx = 0; idx < 8; ++idx) {
            const int ai = idx >> 2, m = idx & 3, rofs = ai * 128 + m * 16;
            const int row = row0 + rofs; float s = 0.f;
            const size_t off = off0 + (size_t)rofs * DM;
            const u32x4 h0 = hr[idx & 3][0], h1 = hr[idx & 3][1], l0 = lr[idx & 3];
            if (idx + 4 < 8) { const size_t o = off0 + (size_t)(128 + (idx & 3) * 16) * DM;
                hr[idx & 3][0] = *(const u32x4*)(XB + o); hr[idx & 3][1] = *(const u32x4*)(XB + o + 8); lr[idx & 3] = *(const u32x4*)(XL + o); }
            f32x4 x[4];
            x[0] = (f32x4){bflo(h0.x), bfhi(h0.x), bflo(h0.y), bfhi(h0.y)} + un_lo8(l0.x);
            x[1] = (f32x4){bflo(h0.z), bfhi(h0.z), bflo(h0.w), bfhi(h0.w)} + un_lo8(l0.y);
            x[2] = (f32x4){bflo(h1.x), bfhi(h1.x), bflo(h1.y), bfhi(h1.y)} + un_lo8(l0.z);
            x[3] = (f32x4){bflo(h1.z), bfhi(h1.z), bflo(h1.w), bfhi(h1.w)} + un_lo8(l0.w);
#pragma unroll
            for (int q = 0; q < 4; ++q) { x[q] = x[q] + scale * acc[ai][q >> 1][m][q & 1];
                s += (x[q][0] * x[q][0] + x[q][1] * x[q][1]) + (x[q][2] * x[q][2] + x[q][3] * x[q][3]); }
            if (last) { float* p = OUT + off;
#pragma unroll
                for (int q = 0; q < 4; ++q) *(f32x4*)(p + 4 * q) = x[q];
            } else {
                u32x4 w0, w1, v0;
                w0.x = pk2(x[0][0], x[0][1]); w0.y = pk2(x[0][2], x[0][3]); w0.z = pk2(x[1][0], x[1][1]); w0.w = pk2(x[1][2], x[1][3]);
                w1.x = pk2(x[2][0], x[2][1]); w1.y = pk2(x[2][2], x[2][3]); w1.z = pk2(x[3][0], x[3][1]); w1.w = pk2(x[3][2], x[3][3]);
                v0.x = pk_lo8(x[0][0] - bflo(w0.x), x[0][1] - bfhi(w0.x), x[0][2] - bflo(w0.y), x[0][3] - bfhi(w0.y));
                v0.y = pk_lo8(x[1][0] - bflo(w0.z), x[1][1] - bfhi(w0.z), x[1][2] - bflo(w0.w), x[1][3] - bfhi(w0.w));
                v0.z = pk_lo8(x[2][0] - bflo(w1.x), x[2][1] - bfhi(w1.x), x[2][2] - bflo(w1.y), x[2][3] - bfhi(w1.y));
                v0.w = pk_lo8(x[3][0] - bflo(w1.z), x[3][1] - bfhi(w1.z), x[3][2] - bflo(w1.w), x[3][3] - bfhi(w1.w));
                u32x4* xb = (u32x4*)(XB + off); xb[0] = w0; xb[1] = w1;
                *(u32x4*)(XL + off) = v0;
                s += shx(s, LANE_, 16); s += shx(s, LANE_, 32);
                if (fq == 0) atomicAdd(ssq_next + row, s);
            }
        }
    }
};

struct EpiProjA {
    static constexpr int BHALF = 8, BTILE = 256;
    static __device__ __forceinline__ int permB(int R) { return pg8::permB_wide(R); }
    bf16_t* O; const float* ssq;
    __device__ __forceinline__ void operator()(const AccT& acc, const Unit& u, int wr, int wc, int fr, int fq) const {
        const int seg = u.pn >> 2; const bool act = (seg == 0) || (seg == 3);
        bf16_t* base = O + (size_t)seg * ((size_t)MTOK * DM);
        const int row0 = u.pm * 256 + wr * 64 + fr, col0 = (u.pn & 3) * 256 + wc * 64 + 16 * fq;
        float rsv[8];
#pragma unroll
        for (int idx = 0; idx < 8; ++idx) rsv[idx] = ssq[row0 + (idx >> 2) * 128 + (idx & 3) * 16];
#pragma unroll
        for (int ai = 0; ai < 2; ++ai)
#pragma unroll
            for (int m = 0; m < 4; ++m) {
                const int row = row0 + ai * 128 + m * 16; const float rs = rsqrtf(rsv[ai * 4 + m] * (1.f / 1024.f) + EPS);
                u32x4 w[2];
#pragma unroll
                for (int bj = 0; bj < 2; ++bj) {
                    float v[8];
#pragma unroll
                    for (int n = 0; n < 2; ++n)
#pragma unroll
                        for (int j = 0; j < 4; ++j) { const float a = acc[ai][bj][m][n][j] * rs; v[n * 4 + j] = act ? siluf_(a) : a; }
                    w[bj].x = pk2(v[0], v[1]); w[bj].y = pk2(v[2], v[3]); w[bj].z = pk2(v[4], v[5]); w[bj].w = pk2(v[6], v[7]);
                }
                u32x4* op = (u32x4*)(base + (size_t)row * DM + col0); op[0] = w[0]; op[1] = w[1];
            }
    }
};

struct EpiProjB {
    static constexpr int BHALF = 64, BTILE = 256;
    static __device__ __forceinline__ int permB(int R) { return pg8::permB_rope2(R); }
    bf16_t* O; const float* ssq; float* hssq; const float* qn; const float* kn; const float* cosT; const float* sinT;
    __device__ __forceinline__ void operator()(const AccT& acc, const Unit& u, int wr, int wc, int fr, int fq) const {
        const int seg = u.pn / 6, hp = u.pn - seg * 6;
        bf16_t* base = O + (size_t)seg * ((size_t)MTOK * ATW);
        const int row0 = u.pm * 256 + wr * 64 + fr, c0 = (wc & 1) * 32 + 8 * fq, head = hp * 2 + (wc >> 1);
        const float* gn = ((seg == 0) ? qn : kn) + (head >> 2) * 128 + c0;
        float rsn[2]; rsn[0] = ssq[row0]; rsn[1] = ssq[row0 + 16];
        const bool rope = seg < 2;
        f32x4 g1a, g1b, g2a, g2b;
        if (rope) { g1a = *(const f32x4*)(gn); g1b = *(const f32x4*)(gn + 4); g2a = *(const f32x4*)(gn + 64); g2b = *(const f32x4*)(gn + 68); }
        const int t0 = row0 & (SEQ - 1);
        const float* cb0 = cosT + (size_t)t0 * 64 + c0; const float* sb0 = sinT + (size_t)t0 * 64 + c0;
        f32x4 tca, tcb, tsa, tsb;
        if (rope) { tca = *(const f32x4*)(cb0); tcb = *(const f32x4*)(cb0 + 4); tsa = *(const f32x4*)(sb0); tsb = *(const f32x4*)(sb0 + 4); }
#pragma unroll
        for (int idx = 0; idx < 8; ++idx) {
            const int ai = idx >> 2, m = idx & 3, rofs = ai * 128 + m * 16;
            const int row = row0 + rofs; const float rs = rsqrtf(rsn[idx & 1] * (1.f / 1024.f) + EPS);
            if (idx + 2 < 8) rsn[idx & 1] = ssq[row0 + ((idx + 2) >> 2) * 128 + ((idx + 2) & 3) * 16];
            float v1[8], v2[8];
#pragma unroll
            for (int n = 0; n < 2; ++n)
#pragma unroll
                for (int j = 0; j < 4; ++j) { v1[n * 4 + j] = acc[ai][0][m][n][j] * rs; v2[n * 4 + j] = acc[ai][1][m][n][j] * rs; }
            if (rope) {
                float s = 0.f;
#pragma unroll
                for (int e = 0; e < 8; ++e) s += v1[e] * v1[e] + v2[e] * v2[e];
                s += shx(s, LANE_, 16); s += shx(s, LANE_, 32);
                if (fq == 0) atomicAdd(hssq + (size_t)row * 24 + seg * 12 + head, s);
#pragma unroll
                for (int e = 0; e < 8; ++e) {
                    const float cs = e < 4 ? tca[e & 3] : tcb[e & 3], sn = e < 4 ? tsa[e & 3] : tsb[e & 3];
                    const float y1 = v1[e] * (e < 4 ? g1a[e & 3] : g1b[e & 3]), y2 = v2[e] * (e < 4 ? g2a[e & 3] : g2b[e & 3]);
                    v1[e] = y1 * cs - y2 * sn; v2[e] = y2 * cs + y1 * sn;
                }
                EPI_SCHED();
                if (idx + 1 < 8) { const int ro = ((idx + 1) >> 2) * 128 + ((idx + 1) & 3) * 16;
                    tca = *(const f32x4*)(cb0 + ro * 64); tcb = *(const f32x4*)(cb0 + ro * 64 + 4); tsa = *(const f32x4*)(sb0 + ro * 64); tsb = *(const f32x4*)(sb0 + ro * 64 + 4); }
                EPI_SCHED();
            }
            u32x4 w1, w2; w1.x = pk2(v1[0], v1[1]); w1.y = pk2(v1[2], v1[3]); w1.z = pk2(v1[4], v1[5]); w1.w = pk2(v1[6], v1[7]);
            w2.x = pk2(v2[0], v2[1]); w2.y = pk2(v2[2], v2[3]); w2.z = pk2(v2[4], v2[5]); w2.w = pk2(v2[6], v2[7]);
            bf16_t* p = base + (size_t)row * ATW + head * 128 + c0;
            *(u32x4*)p = w1; *(u32x4*)(p + 64) = w2;
        }
    }
};

struct EpiStoreBf16 {
    static constexpr int BHALF = 8, BTILE = 256;
    static __device__ __forceinline__ int permB(int R) { return pg8::permB_wide(R); }
    bf16_t* T;
    __device__ __forceinline__ void operator()(const AccT& acc, const Unit& u, int wr, int wc, int fr, int fq) const {
        const int row0 = u.pm * 256 + wr * 64 + fr, col0 = u.pn * 256 + wc * 64 + 16 * fq;
#pragma unroll
        for (int ai = 0; ai < 2; ++ai)
#pragma unroll
            for (int m = 0; m < 4; ++m) {
                u32x4 w[2];
#pragma unroll
                for (int bj = 0; bj < 2; ++bj) { w[bj].x = pk2(acc[ai][bj][m][0][0], acc[ai][bj][m][0][1]); w[bj].y = pk2(acc[ai][bj][m][0][2], acc[ai][bj][m][0][3]); w[bj].z = pk2(acc[ai][bj][m][1][0], acc[ai][bj][m][1][1]); w[bj].w = pk2(acc[ai][bj][m][1][2], acc[ai][bj][m][1][3]); }
                u32x4* op = (u32x4*)(T + (size_t)(row0 + ai * 128 + m * 16) * DM + col0); op[0] = w[0]; op[1] = w[1];
            }
    }
};
struct EpiGateMerge {
    static constexpr int BHALF = 1024, BTILE = 128;
    static __device__ __forceinline__ int permB(int R) { return pg8::permB_std(R); }
    bf16_t* T1; const bf16_t* T2; const float* ssq;
    __device__ __forceinline__ void operator()(const AccT& acc, const Unit& u, int wr, int wc, int fr, int fq) const {
        const int row0 = u.pm * 256 + wr * 64 + fr, col0 = u.pn * 128 + wc * 32 + 8 * fq;
        const size_t off0 = (size_t)row0 * DM + col0;
        float rsv[8];
#pragma unroll
        for (int idx = 0; idx < 8; ++idx) rsv[idx] = ssq[row0 + (idx >> 2) * 128 + (idx & 3) * 16];
        u32x4 ra[4], rb[4];
#pragma unroll
        for (int i = 0; i < 4; ++i) { const size_t o = off0 + (size_t)(i * 16) * DM; ra[i] = *(const u32x4*)(T1 + o); rb[i] = *(const u32x4*)(T2 + o); }
        EPI_SCHED();
#pragma unroll
        for (int idx = 0; idx < 8; ++idx) {
            const int ai = idx >> 2, m = idx & 3;
            const size_t off = off0 + (size_t)(ai * 128 + m * 16) * DM;
            const float rs = rsqrtf(rsv[idx] * (1.f / 1024.f) + EPS);
            const u32x4 ta = ra[idx & 3], tb = rb[idx & 3];
            if (idx + 4 < 8) { const size_t o = off0 + (size_t)(128 + (idx & 3) * 16) * DM; ra[idx & 3] = *(const u32x4*)(T1 + o); rb[idx & 3] = *(const u32x4*)(T2 + o); }
            const float ya[8] = {bflo(ta.x), bfhi(ta.x), bflo(ta.y), bfhi(ta.y), bflo(ta.z), bfhi(ta.z), bflo(ta.w), bfhi(ta.w)};
            const float yb[8] = {bflo(tb.x), bfhi(tb.x), bflo(tb.y), bfhi(tb.y), bflo(tb.z), bfhi(tb.z), bflo(tb.w), bfhi(tb.w)};
            float o[8];
#pragma unroll
            for (int n = 0; n < 2; ++n)
#pragma unroll
                for (int j = 0; j < 4; ++j) { const int e = n * 4 + j; o[e] = sigmoidf_(acc[ai][0][m][n][j] * rs) * ya[e] + sigmoidf_(acc[ai][1][m][n][j] * rs) * yb[e]; }
            u32x4 w; w.x = pk2(o[0], o[1]); w.y = pk2(o[2], o[3]); w.z = pk2(o[4], o[5]); w.w = pk2(o[6], o[7]);
            *(u32x4*)(T1 + off) = w;
            EPI_SCHED();
        }
    }
};

struct Args {
    const float* in[16];
    float* out; unsigned char* ws;
};

__device__ __forceinline__ void transpose_item(const float* W, int K, int Nsrc, const float* gain, bf16_t* WT, int dst_row0, int src_col0, int k0, LAS float* scr, int lane) {
#pragma unroll 8
    for (int i = 0; i < 32; ++i) { const int kk = 2 * i + (lane >> 5); const float g = gain ? gain[k0 + kk] : 1.f; scr[kk * 33 + (lane & 31)] = W[(size_t)(k0 + kk) * Nsrc + src_col0 + (lane & 31)] * g; }
    asm volatile("s_waitcnt lgkmcnt(0)" ::: "memory");
    const int c = lane & 7;
#pragma unroll
    for (int j = 0; j < 4; ++j) { const int n = (lane >> 3) + 8 * j; const LAS float* s = scr + (8 * c) * 33 + n;
        u32x4 o; o.x = pk2(s[0 * 33], s[1 * 33]); o.y = pk2(s[2 * 33], s[3 * 33]); o.z = pk2(s[4 * 33], s[5 * 33]); o.w = pk2(s[6 * 33], s[7 * 33]);
        *(u32x4*)(WT + (size_t)(dst_row0 + n) * K + k0 + 8 * c) = o; }
    asm volatile("s_waitcnt lgkmcnt(0)" ::: "memory");
}

__device__ __forceinline__ void convert_weights(int wv, const Args& a, int l, LAS unsigned char* lds) {
    const int tid = opaque_tid(wv), lane = tid & 63, wave = tid >> 6;
    LAS float* scr = (LAS float*)(lds + wave * 16384);
    unsigned char* ws = opaque_ptr(a.ws);
    const int gw = blockIdx.x * 8 + wave, NGW = NWG * 8;
    constexpr int I1 = 16 * 176, I1O = 44 * 32, IIN = 16 * 336, IA = 16 * 32, IB = 8 * 32, IO = 16 * 32;
    constexpr int NIT = 2 * I1 + 2 * I1O + IIN + IA + IB + IO;
    for (int it = gw; it < NIT; it += NGW) {
        int r = it;
        if (r < 2 * I1) {
            const int which = r / I1; r -= which * I1;
            const float* W = (which ? a.in[14] : a.in[2]) + (size_t)l * DM * 2 * DFF; const float* gn = (which ? a.in[13] : a.in[1]) + l * DM;
            bf16_t* WT = (bf16_t*)(ws + (which ? W_2T : W_1T));
            const int kb = r / 176, nb = r % 176, n0 = nb * 32, pn = n0 >> 8, bj = (n0 >> 7) & 1, i0 = n0 & 127;
            transpose_item(W, DM, 2 * DFF, gn, WT, n0, bj * DFF + 128 * pn + i0, kb * 64, scr, lane); continue; }
        r -= 2 * I1;
        if (r < 2 * I1O) {
            const int which = r / I1O; r -= which * I1O;
            const float* W = (which ? a.in[15] : a.in[3]) + (size_t)l * DFF * DM; bf16_t* WT = (bf16_t*)(ws + (which ? W_2O : W_1O));
            const int kb = r / 32, nb = r % 32;
            transpose_item(W, DFF, DM, nullptr, WT, nb * 32, nb * 32, kb * 64, scr, lane); continue; }
        r -= 2 * I1O;
        if (r < IIN) { const float* W = a.in[5] + (size_t)l * DM * PIN; const float* gn = a.in[4] + l * DM; bf16_t* WT = (bf16_t*)(ws + W_IN);
            const int kb = r / 336, nb = r % 336;
            transpose_item(W, DM, PIN, gn, WT, nb * 32, nb * 32, kb * 64, scr, lane); continue; }
        r -= IIN;
        if (r < IA) { const float* W = a.in[10] + (size_t)l * DM * DM; bf16_t* WT = (bf16_t*)(ws + W_A); const int kb = r / 32, nb = r % 32;
            transpose_item(W, DM, DM, nullptr, WT, nb * 32, nb * 32, kb * 64, scr, lane); continue; }
        r -= IA;
        if (r < IB) { const float* W = a.in[11] + (size_t)l * 512 * DM; bf16_t* WT = (bf16_t*)(ws + W_B); const int kb = r / 32, nb = r % 32;
            transpose_item(W, 512, DM, nullptr, WT, nb * 32, nb * 32, kb * 64, scr, lane); continue; }
        r -= IB;
        { const float* W = a.in[12] + (size_t)l * DM * DM; bf16_t* WT = (bf16_t*)(ws + W_O); const int kb = r / 32, nb = r % 32;
            transpose_item(W, DM, DM, nullptr, WT, nb * 32, nb * 32, kb * 64, scr, lane); }
    }
}

__device__ __forceinline__ void prologue_x(int wv, const Args& a) {
    const int tid = opaque_tid(wv), lane = tid & 63, wave = tid >> 6;
    const int gw = blockIdx.x * 8 + wave, NGW = NWG * 8;
    const int gt = blockIdx.x * NTHR + tid, GT = NWG * NTHR;
    float* ssq = (float*)(a.ws + WS_SSQ);
    bf16_t* XB = (bf16_t*)(a.ws + WS_XB);
    for (int i = gt; i < 6 * MTOK; i += GT) ssq[MTOK + i] = 0.f;
    float* cosT = (float*)(a.ws + WS_COS); float* sinT = (float*)(a.ws + WS_SIN);
    for (int i = gt; i < SEQ * 64; i += GT) { const int t = i >> 6, j = i & 63; const double inv = exp(-(double)j * (9.210340371976184 / 64.0)); double s, c; sincos((double)t * inv, &s, &c); cosT[i] = (float)c; sinT[i] = (float)s; }
    for (int m = gw; m < MTOK; m += NGW) {
        const f32x4* xr = (const f32x4*)(a.in[0] + (size_t)m * DM) + lane;
        u32x2* xb = (u32x2*)(XB + (size_t)m * DM) + lane; unsigned* xl = (unsigned*)((unsigned char*)(a.ws + WS_XL) + (size_t)m * DM) + lane;
        float s = 0.f;
#pragma unroll
        for (int j = 0; j < 4; ++j) { const f32x4 v = xr[64 * j]; u32x2 w; w.x = pk2(v[0], v[1]); w.y = pk2(v[2], v[3]); xb[64 * j] = w; xl[64 * j] = pk_lo8(v[0] - bflo(w.x), v[1] - bfhi(w.x), v[2] - bflo(w.y), v[3] - bfhi(w.y)); s += (v[0] * v[0] + v[1] * v[1]) + (v[2] * v[2] + v[3] * v[3]); }
#pragma unroll
        for (int o = 1; o < 64; o <<= 1) s += shx(s, lane, o);
        if (lane == 0) ssq[m] = s;
    }
}

constexpr int HG_QH = 0, HG_KH = 17408, HG_EM = 34816  , HG_KTT = 52224, HG_VTT = 70656, HG_AM = 89088, HG_ST = 98304, HG_TOT = 133120, HG_DV = 135168, HG_SSQP = 135680;
template <bool FULL>
__device__ __forceinline__ void hgrn_pass(int wv, const Args& a, int l, LAS unsigned char* lds, int item, bool dmy) {
    const int tid = opaque_tid(wv), lane = tid & 63, wid = __builtin_amdgcn_readfirstlane(tid >> 6), fr = lane & 15, fq = lane >> 4;
    const int ch = tid & 127, seg = __builtin_amdgcn_readfirstlane(tid >> 7);
    const int b = item >> 6, h = (item >> 3) & 7, p = item & 7;
    const size_t row_base = (size_t)b * SEQ + (size_t)p * 1024;
    const bf16_t* HQ = (const bf16_t*)(a.ws + WS_HQ); const bf16_t* HF = (const bf16_t*)(a.ws + WS_HF); const bf16_t* HI = (const bf16_t*)(a.ws + WS_HI); const bf16_t* HGt = (const bf16_t*)(a.ws + WS_HG);
    bf16_t* OA = dmy ? (bf16_t*)(a.ws + WS_DUMMY) - (size_t)(b * SEQ + p * 1024) * DM : (bf16_t*)a.out;
    float* US = (float*)(a.ws + WS_US); float* DT = (float*)(a.ws + WS_DT);
    float lb = 0.f;
    if (l == 1) { const float l0 = a.in[6][h * 128 + ch], l1 = a.in[6][DM + h * 128 + ch]; lb = 1.f / (1.f + expf(l0 - l1)); }
    const float oml = 1.f - lb;
    LAS float* TOT = (LAS float*)(lds + HG_TOT); LAS float* DV = (LAS float*)(lds + HG_DV); LAS float* SSQP = (LAS float*)(lds + HG_SSQP); LAS float* EM = (LAS float*)(lds + HG_EM);
    const int ti = wid & 3, dvh = wid >> 2;
    f32x4 sacc[8];
#pragma unroll
    for (int j = 0; j < 8; ++j) sacc[j] = (f32x4){0.f, 0.f, 0.f, 0.f};
    float gsum = 0.f;
    if (FULL) {
        for (int pp = 0; pp < p; ++pp) {
            const int it2 = item - p + pp;
            const f32x4 dd = *(const f32x4*)(DT + (size_t)it2 * 128 + wid * 16 + 4 * fq);
#pragma unroll
            for (int j = 0; j < 8; ++j)
#pragma unroll
                for (int r = 0; r < 4; ++r) sacc[j][r] = sacc[j][r] * dd[r] + US[((size_t)it2 * 128 + wid * 16 + 4 * fq + r) * 128 + j * 16 + fr];
        }
    }
    const unsigned gcol = (unsigned)(h * 128 + ch);
    unsigned cHF[8], cHI[8], cHQ[8];
#define HG_LOAD(dstF, dstI, dstQ, cc) do { const size_t r0_ = (row_base + (size_t)(cc) * 64 + seg * 16) * DM; \
        _Pragma("unroll") for (int i_ = 0; i_ < 8; ++i_) { const bf16_t* bF_ = HF + r0_ + (size_t)(2 * i_) * DM; const bf16_t* bI_ = HI + r0_ + (size_t)(2 * i_) * DM; const bf16_t* bQ_ = HQ + r0_ + (size_t)(2 * i_) * DM; \
            dstF[i_] = (unsigned)bF_[gcol] | ((unsigned)bF_[gcol + DM] << 16); \
            dstI[i_] = (unsigned)bI_[gcol] | ((unsigned)bI_[gcol + DM] << 16); \
            if (FULL) dstQ[i_] = (unsigned)bQ_[gcol] | ((unsigned)bQ_[gcol + DM] << 16); } \
        } while (0)
    HG_LOAD(cHF, cHI, cHQ, 0);
    for (int c = 0; c < 16; ++c) {
        unsigned nHF[8], nHI[8], nHQ[8];
        { const int cn = c < 15 ? c + 1 : 15; HG_LOAD(nHF, nHI, nHQ, cn); }
        float cum[16], kk[16];
        {
            float run = 0.f;
#pragma unroll
            for (int i = 0; i < 16; ++i) {
                const float x = (i & 1) ? bfhi(cHF[i >> 1]) : bflo(cHF[i >> 1]);
                const float e = __expf(-x); const float sg = fast_rcp(1.f + e);
                const float f = lb + oml * sg;
                kk[i] = oml * (1.f - sg);
                run += __logf(f); cum[i] = run;
            }
            TOT[seg * 128 + ch] = run;
        }
        __syncthreads();
        float prefix = 0.f; const float t0 = TOT[ch], t1 = TOT[128 + ch], t2 = TOT[256 + ch], t3 = TOT[384 + ch];
        if (seg >= 1) prefix += t0; if (seg >= 2) prefix += t1; if (seg >= 3) prefix += t2;
        const float gmid = t0 + t1, glast = (t0 + t1) + (t2 + t3);
        if (seg == 0) { DV[ch] = __expf(glast); gsum += glast; if (FULL) EM[ch] = __expf(gmid); }
        {
            unsigned kt[8];
            if (FULL) {
                const float El = __expf(glast - gmid);
#pragma unroll
                for (int i = 0; i < 16; i += 2) {
                    const float d0 = fmaxf(prefix + cum[i] - gmid, -80.f), d1 = fmaxf(prefix + cum[i + 1] - gmid, -80.f);
                    const float E0 = __expf(d0), E1 = __expf(d1), R0 = fast_rcp(E0), R1 = fast_rcp(E1);
                    const float kh0 = kk[i] * R0, kh1 = kk[i + 1] * R1;
                    kt[i >> 1] = pk2(kh0 * El, kh1 * El);
                    const unsigned qh = pk2(bflo(cHQ[i >> 1]) * E0, bfhi(cHQ[i >> 1]) * E1), kh = pk2(kh0, kh1);
                    const int tA = seg * 16 + i;
                    *(LAS bf16_t*)(lds + HG_QH + (tA * 136 + ch) * 2) = (bf16_t)(qh & 0xffffu);
                    *(LAS bf16_t*)(lds + HG_QH + ((tA + 1) * 136 + ch) * 2) = (bf16_t)(qh >> 16);
                    *(LAS bf16_t*)(lds + HG_KH + (tA * 136 + ch) * 2) = (bf16_t)(kh & 0xffffu);
                    *(LAS bf16_t*)(lds + HG_KH + ((tA + 1) * 136 + ch) * 2) = (bf16_t)(kh >> 16);
                }
            } else {
#pragma unroll
                for (int i = 0; i < 16; i += 2) kt[i >> 1] = pk2(kk[i] * __expf(glast - (prefix + cum[i])), kk[i + 1] * __expf(glast - (prefix + cum[i + 1])));
            }
            LAS u32x4* kp = (LAS u32x4*)(lds + HG_KTT + (ch * 72 + seg * 16) * 2); LAS u32x4* vp = (LAS u32x4*)(lds + HG_VTT + (ch * 72 + seg * 16) * 2);
            kp[0] = (u32x4){kt[0], kt[1], kt[2], kt[3]}; kp[1] = (u32x4){kt[4], kt[5], kt[6], kt[7]};
            vp[0] = (u32x4){cHI[0], cHI[1], cHI[2], cHI[3]}; vp[1] = (u32x4){cHI[4], cHI[5], cHI[6], cHI[7]};
        }
        __syncthreads();
        f32x4 oacc[4]; f32x4 gn[4]; u32x2 cHG[4];
        if (FULL) {
            {
                const f32x4 em = *(const LAS f32x4*)(lds + HG_EM + (wid * 16 + 4 * fq) * 4);
#pragma unroll
                for (int j = 0; j < 8; ++j) { u32x2 w; w.x = pk2(sacc[j][0] * em[0], sacc[j][1] * em[1]); w.y = pk2(sacc[j][2] * em[2], sacc[j][3] * em[3]); *(LAS u32x2*)(lds + HG_ST + ((j * 16 + fr) * 136 + wid * 16 + 4 * fq) * 2) = w; }
            }
            {
                const int tiA = wid >> 1;
#pragma unroll
                for (int q = 0; q < 2; ++q) {
                    const int sj = (wid & 1) * 2 + q;
                    f32x4 ac = (f32x4){0.f, 0.f, 0.f, 0.f};
#pragma unroll
                    for (int k4 = 0; k4 < 4; ++k4) {
                        const bf16x8 av = lds_ld16(lds + HG_QH + ((tiA * 16 + fr) * 136 + k4 * 32 + 8 * fq) * 2);
                        const bf16x8 bv = lds_ld16(lds + HG_KH + ((sj * 16 + fr) * 136 + k4 * 32 + 8 * fq) * 2);
                        ac = mfma16(av, bv, ac);
                    }
                    const int s = sj * 16 + fr, tb0 = tiA * 16 + 4 * fq;
                    const unsigned w0 = pk2(s <= tb0 ? ac[0] : 0.f, s <= tb0 + 1 ? ac[1] : 0.f), w1 = pk2(s <= tb0 + 2 ? ac[2] : 0.f, s <= tb0 + 3 ? ac[3] : 0.f);
                    *(LAS bf16_t*)(lds + HG_AM + ((tb0 + 0) * 72 + s) * 2) = (bf16_t)(w0 & 0xffffu);
                    *(LAS bf16_t*)(lds + HG_AM + ((tb0 + 1) * 72 + s) * 2) = (bf16_t)(w0 >> 16);
                    *(LAS bf16_t*)(lds + HG_AM + ((tb0 + 2) * 72 + s) * 2) = (bf16_t)(w1 & 0xffffu);
                    *(LAS bf16_t*)(lds + HG_AM + ((tb0 + 3) * 72 + s) * 2) = (bf16_t)(w1 >> 16);
                }
            }
            __syncthreads();
            { const size_t or_ = row_base + (size_t)c * 64 + ti * 16 + fr;
#pragma unroll
              for (int jj = 0; jj < 4; ++jj) { cHG[jj] = *(const u32x2*)(HGt + or_ * DM + h * 128 + (dvh * 4 + jj) * 16 + 4 * fq); gn[jj] = *(const f32x4*)(a.in[7] + l * DM + h * 128 + (dvh * 4 + jj) * 16 + 4 * fq); } }
#pragma unroll
            for (int jj = 0; jj < 4; ++jj) oacc[jj] = (f32x4){0.f, 0.f, 0.f, 0.f};
#pragma unroll
            for (int k2 = 0; k2 < 2; ++k2) {
                const bf16x8 bv = lds_ld16(lds + HG_AM + ((ti * 16 + fr) * 72 + k2 * 32 + 8 * fq) * 2);
#pragma unroll
                for (int jj = 0; jj < 4; ++jj) { const bf16x8 av = lds_ld16(lds + HG_VTT + (((dvh * 4 + jj) * 16 + fr) * 72 + k2 * 32 + 8 * fq) * 2); oacc[jj] = mfma16(av, bv, oacc[jj]); }
            }
#pragma unroll
            for (int k4 = 0; k4 < 4; ++k4) {
                const bf16x8 bv = lds_ld16(lds + HG_QH + ((ti * 16 + fr) * 136 + k4 * 32 + 8 * fq) * 2);
#pragma unroll
                for (int jj = 0; jj < 4; ++jj) { const bf16x8 av = lds_ld16(lds + HG_ST + (((dvh * 4 + jj) * 16 + fr) * 136 + k4 * 32 + 8 * fq) * 2); oacc[jj] = mfma16(av, bv, oacc[jj]); }
            }
            float s = 0.f;
#pragma unroll
            for (int jj = 0; jj < 4; ++jj) s += (oacc[jj][0] * oacc[jj][0] + oacc[jj][1] * oacc[jj][1]) + (oacc[jj][2] * oacc[jj][2] + oacc[jj][3] * oacc[jj][3]);
            s += shx(s, LANE_, 16); s += shx(s, LANE_, 32);
            if (fq == 0) SSQP[dvh * 64 + ti * 16 + fr] = s;
        }
        {
            const f32x4 dd = *(const LAS f32x4*)(lds + HG_DV + (wid * 16 + 4 * fq) * 4);
#pragma unroll
            for (int j = 0; j < 8; ++j) sacc[j] = sacc[j] * dd;
#pragma unroll
            for (int k2 = 0; k2 < 2; ++k2) {
                const bf16x8 av = lds_ld16(lds + HG_KTT + ((wid * 16 + fr) * 72 + k2 * 32 + 8 * fq) * 2);
#pragma unroll
                for (int j = 0; j < 8; ++j) { const bf16x8 bv = lds_ld16(lds + HG_VTT + ((j * 16 + fr) * 72 + k2 * 32 + 8 * fq) * 2); sacc[j] = mfma16(av, bv, sacc[j]); }
            }
        }
        __syncthreads();
        if (FULL) {
            const int t = ti * 16 + fr;
            const float tot = SSQP[t] + SSQP[64 + t];
            const float rs = rsqrtf(tot * (1.f / 128.f) + EPS);
            const size_t orow = row_base + (size_t)c * 64 + t;
#pragma unroll
            for (int jj = 0; jj < 4; ++jj) {
                const int dv0 = (dvh * 4 + jj) * 16 + 4 * fq;
                const u32x2 hg = cHG[jj];
                const float o0 = oacc[jj][0] * rs * gn[jj][0] * bflo(hg.x), o1 = oacc[jj][1] * rs * gn[jj][1] * bfhi(hg.x), o2 = oacc[jj][2] * rs * gn[jj][2] * bflo(hg.y), o3 = oacc[jj][3] * rs * gn[jj][3] * bfhi(hg.y);
                u32x2 w; w.x = pk2(o0, o1); w.y = pk2(o2, o3);
                *(u32x2*)(OA + orow * DM + h * 128 + dv0) = w;
            }
        }
#pragma unroll
        for (int i = 0; i < 8; ++i) { cHF[i] = nHF[i]; cHI[i] = nHI[i]; if (FULL) cHQ[i] = nHQ[i]; }
    }
#undef HG_LOAD
    if (!FULL) {
#pragma unroll
        for (int j = 0; j < 8; ++j)
#pragma unroll
            for (int r = 0; r < 4; ++r) US[((size_t)item * 128 + wid * 16 + 4 * fq + r) * 128 + j * 16 + fr] = sacc[j][r];
        if (seg == 0) DT[(size_t)item * 128 + ch] = __expf(gsum);
    }
    __syncthreads();
}

constexpr int AT_K = 0, AT_V = 69632;
struct AttnIt { int b, g, hh, r, n, d, head; size_t tb; };
__device__ __forceinline__ AttnIt attn_decode(int item) {
    AttnIt t; const int blk = item & 63; t.hh = (item >> 6) & 3; const int gb = item >> 8; t.g = gb % 3; t.b = gb / 3;
    const int dsh = 2 * t.g; t.d = 1 << dsh; const int nb = 64 >> dsh; t.r = blk / nb; t.n = blk % nb; t.head = t.g * 4 + t.hh; t.tb = (size_t)t.b * SEQ + t.r; return t;
}
__device__ __forceinline__ void attn_phase(int wv, const Args& a, LAS unsigned char* lds, int w, bool dmy) {
    const int tid = opaque_tid(wv), lane = tid & 63, wid = __builtin_amdgcn_readfirstlane(tid >> 6), fr = lane & 15, fq = lane >> 4;
    bf16_t* AQ = (bf16_t*)(a.ws + WS_AQ); const bf16_t* AK = (const bf16_t*)(a.ws + WS_AK); const bf16_t* AV = (const bf16_t*)(a.ws + WS_AV);
    const float* HS = (const float*)(a.ws + WS_HSSQ); float* LSE = (float*)(a.ws + WS_LSE);
    const int krow = tid >> 4, kc = tid & 15;
    const int vc = tid >> 6, vrow = (tid & 63) * 2;
    const int qi = 16 * wid + fr;
    u32x4 kr[4], vr[4]; float rk[4]; bf16x8 qf[4]; float qs;
#define AT_LOADBLK(T, blkn) do { _Pragma("unroll") for (int i_ = 0; i_ < 4; ++i_) { \
        const size_t tokk_ = (T).tb + (size_t)(128 * (blkn) + krow + 32 * i_) * (T).d; kr[i_] = *(const u32x4*)(AK + tokk_ * ATW + (T).head * 128 + 8 * kc); rk[i_] = HS[tokk_ * 24 + 12 + (T).head]; \
        const size_t tokv_ = (T).tb + (size_t)(128 * (blkn) + vrow + (i_ & 1)) * (T).d; vr[i_] = *(const u32x4*)(AV + tokv_ * ATW + (T).head * 128 + 8 * (vc + 8 * (i_ >> 1))); } } while (0)
#define AT_LOADQ(T) do { const size_t tq_ = (T).tb + (size_t)(128 * (T).n + qi) * (T).d; \
        _Pragma("unroll") for (int k4_ = 0; k4_ < 4; ++k4_) qf[k4_] = *(const bf16x8*)(AQ + tq_ * ATW + (T).head * 128 + k4_ * 32 + 8 * fq); qs = HS[tq_ * 24 + (T).head]; } while (0)
#define AT_WRITEBLK(slot) do { _Pragma("unroll") for (int i_ = 0; i_ < 4; ++i_) { \
        const float rk_ = rsqrtf(rk[i_] * (1.f / 128.f) + EPS); const u32x4 v_ = kr[i_]; u32x4 w_; \
        w_.x = pk2(bflo(v_.x) * rk_, bfhi(v_.x) * rk_); w_.y = pk2(bflo(v_.y) * rk_, bfhi(v_.y) * rk_); w_.z = pk2(bflo(v_.z) * rk_, bfhi(v_.z) * rk_); w_.w = pk2(bflo(v_.w) * rk_, bfhi(v_.w) * rk_); \
        *(LAS u32x4*)(lds + AT_K + (((slot) * 128 + krow + 32 * i_) * 136 + 8 * kc) * 2) = w_; \
        } \
        _Pragma("unroll") for (int i_ = 0; i_ < 2; ++i_) { const u32x4 e_ = vr[2 * i_], o_ = vr[2 * i_ + 1]; \
        LAS unsigned* vp_ = (LAS unsigned*)(lds + AT_V + ((8 * (vc + 8 * i_)) * 264 + (slot) * 128 + vrow) * 2); \
        vp_[0 * 132] = (e_.x & 0xffffu) | (o_.x << 16); vp_[1 * 132] = (e_.x >> 16) | (o_.x & 0xffff0000u); vp_[2 * 132] = (e_.y & 0xffffu) | (o_.y << 16); vp_[3 * 132] = (e_.y >> 16) | (o_.y & 0xffff0000u); \
        vp_[4 * 132] = (e_.z & 0xffffu) | (o_.z << 16); vp_[5 * 132] = (e_.z >> 16) | (o_.z & 0xffff0000u); vp_[6 * 132] = (e_.w & 0xffffu) | (o_.w << 16); vp_[7 * 132] = (e_.w >> 16) | (o_.w & 0xffff0000u); } } while (0)
    AttnIt T = attn_decode(12 * w);
    if (T.n > 0) { AT_LOADBLK(T, T.n - 1); AT_WRITEBLK((T.n & 1) ^ 1); }
    AT_LOADBLK(T, T.n); AT_LOADQ(T);
    for (int it = 0; it < 12; ++it) {
        const int n = T.n, sl = n & 1, head = T.head;
        if (n == 0) {
            unsigned zz; asm volatile("v_mov_b32 %0, 0" : "=v"(zz)); const u32x4 z = (u32x4){zz, zz, zz, zz};
#pragma unroll
            for (int i = 0; i < 4; ++i) { *(LAS u32x4*)(lds + AT_K + (((sl ^ 1) * 128 + krow + 32 * i) * 136 + 8 * kc) * 2) = z; }
#pragma unroll
            for (int i = 0; i < 4; ++i) { const int id = tid + 512 * i, dvr = id >> 4, c16 = id & 15; *(LAS u32x4*)(lds + AT_V + (dvr * 264 + (sl ^ 1) * 128 + 8 * c16) * 2) = z; }
        }
        AT_WRITEBLK(sl);
        bf16x8 qc[4];
#pragma unroll
        for (int k4 = 0; k4 < 4; ++k4) qc[k4] = qf[k4];
        const float qscale = rsqrtf(qs * (1.f / 128.f) + EPS) * 0.08838834764831845f;
        const size_t tokq = T.tb + (size_t)(128 * n + qi) * T.d;
        __syncthreads();
        if (it < 11) { T = attn_decode(12 * w + it + 1);
            AT_LOADBLK(T, T.n); AT_LOADQ(T); }
        const int px = (sl ^ 1) << 3;
        const int lo2 = (wid & ~1) < 6 ? (wid & ~1) : 6;
        f32x4 sT[10];
        float mx = -INFINITY;
#pragma unroll
        for (int i = 0; i < 10; ++i) {
            const int kt = lo2 + i, pkt = kt ^ px;
            f32x4 ac = (f32x4){0.f, 0.f, 0.f, 0.f};
#pragma unroll
            for (int k4 = 0; k4 < 4; ++k4) ac = mfma16(lds_ld16(lds + AT_K + ((pkt * 16 + fr) * 136 + k4 * 32 + 8 * fq) * 2), qc[k4], ac);
#pragma unroll
            for (int rr = 0; rr < 4; ++rr) {
                const int ki = kt * 16 + 4 * fq + rr;
                const bool valid = (ki >= qi) && (ki <= qi + 128) && (n > 0 || ki >= 128);
                const float sv = valid ? ac[rr] * qscale : -INFINITY;
                ac[rr] = sv; mx = fmaxf(mx, sv);
            }
            sT[i] = ac;
        }
        mx = fmaxf(mx, shx(mx, LANE_, 16)); mx = fmaxf(mx, shx(mx, LANE_, 32));
        float sum = 0.f;
#pragma unroll
        for (int i = 0; i < 10; ++i)
#pragma unroll
            for (int rr = 0; rr < 4; ++rr) { const float pv = __expf(sT[i][rr] - mx); sT[i][rr] = pv; sum += pv; }
        sum += shx(sum, LANE_, 16); sum += shx(sum, LANE_, 32);
        f32x4 oacc[8];
#pragma unroll
        for (int j = 0; j < 8; ++j) oacc[j] = (f32x4){0.f, 0.f, 0.f, 0.f};
#pragma unroll
        for (int pp = 0; pp < 5; ++pp) {
            const int pk0 = (lo2 + 2 * pp) ^ px, pk1 = (lo2 + 2 * pp + 1) ^ px;
            u32x4 pw; pw.x = pk2(sT[2 * pp][0], sT[2 * pp][1]); pw.y = pk2(sT[2 * pp][2], sT[2 * pp][3]); pw.z = pk2(sT[2 * pp + 1][0], sT[2 * pp + 1][1]); pw.w = pk2(sT[2 * pp + 1][2], sT[2 * pp + 1][3]);
            const bf16x8 pf = __builtin_bit_cast(bf16x8, pw);
#pragma unroll
            for (int j = 0; j < 8; ++j) {
                const u32x2 v0 = *(const LAS u32x2*)(lds + AT_V + ((j * 16 + fr) * 264 + pk0 * 16 + 4 * fq) * 2);
                const u32x2 v1 = *(const LAS u32x2*)(lds + AT_V + ((j * 16 + fr) * 264 + pk1 * 16 + 4 * fq) * 2);
                const u32x4 vw = (u32x4){v0.x, v0.y, v1.x, v1.y};
                oacc[j] = mfma16(__builtin_bit_cast(bf16x8, vw), pf, oacc[j]);
            }
        }
        const float inv = 1.f / sum;
#pragma unroll
        for (int j = 0; j < 8; ++j) { u32x2 wv; wv.x = pk2(oacc[j][0] * inv, oacc[j][1] * inv); wv.y = pk2(oacc[j][2] * inv, oacc[j][3] * inv);
            *(u32x2*)((dmy ? (bf16_t*)(a.ws + WS_DUMMY) + (size_t)qi * ATW : AQ + tokq * ATW) + head * 128 + j * 16 + 4 * fq) = wv; }
        if (fq == 0) (dmy ? (float*)(a.ws + WS_DUMMY + MiB) + qi * 12 : LSE + tokq * 12)[head] = mx + __logf(sum);
        __syncthreads();
    }
#undef AT_LOADBLK
#undef AT_LOADQ
#undef AT_WRITEBLK
}

__device__ __forceinline__ void attn_merge(int wv, const Args& a) {
    const int gt = blockIdx.x * NTHR + opaque_tid(wv), GT = NWG * NTHR;
    const bf16_t* OG = (const bf16_t*)(a.ws + WS_AQ); const float* LSE = (const float*)(a.ws + WS_LSE); bf16_t* OB = (bf16_t*)(a.ws + WS_OB);
    for (int i = gt; i < MTOK * 64; i += GT) {
        const int tok = i >> 6, hh = (i >> 4) & 3, c = i & 15;
        const float l0 = LSE[(size_t)tok * 12 + hh], l1 = LSE[(size_t)tok * 12 + 4 + hh], l2 = LSE[(size_t)tok * 12 + 8 + hh];
        const float mxl = fmaxf(l0, fmaxf(l1, l2));
        float a0 = __expf(l0 - mxl), a1 = __expf(l1 - mxl), a2 = __expf(l2 - mxl); const float inv = 1.f / (a0 + a1 + a2); a0 *= inv; a1 *= inv; a2 *= inv;
        const u32x4 v0 = *(const u32x4*)(OG + (size_t)tok * ATW + hh * 128 + 8 * c), v1 = *(const u32x4*)(OG + (size_t)tok * ATW + (4 + hh) * 128 + 8 * c), v2 = *(const u32x4*)(OG + (size_t)tok * ATW + (8 + hh) * 128 + 8 * c);
        u32x4 w;
        w.x = pk2(a0 * bflo(v0.x) + a1 * bflo(v1.x) + a2 * bflo(v2.x), a0 * bfhi(v0.x) + a1 * bfhi(v1.x) + a2 * bfhi(v2.x));
        w.y = pk2(a0 * bflo(v0.y) + a1 * bflo(v1.y) + a2 * bflo(v2.y), a0 * bfhi(v0.y) + a1 * bfhi(v1.y) + a2 * bfhi(v2.y));
        w.z = pk2(a0 * bflo(v0.z) + a1 * bflo(v1.z) + a2 * bflo(v2.z), a0 * bfhi(v0.z) + a1 * bfhi(v1.z) + a2 * bfhi(v2.z));
        w.w = pk2(a0 * bflo(v0.w) + a1 * bflo(v1.w) + a2 * bflo(v2.w), a0 * bfhi(v0.w) + a1 * bfhi(v1.w) + a2 * bfhi(v2.w));
        *(u32x4*)(OB + (size_t)tok * 512 + hh * 128 + 8 * c) = w;
    }
}


#define XB_TMO      128
#define XB_XCNT(j)  (256  + 64 * (j))
#define XB_XSUB(j)  (1280 + 64 * (j))
#define XB_XGEN(j)  (2304 + 64 * (j))
#define XB_TOP      3328
#define XB_TOPGEN   3392
#define XCD_BAR_WORDS 3456
#define XB_SPIN_CAP (1u << 18)
__device__ __forceinline__ unsigned xb_ld(unsigned* p)              { return __hip_atomic_load(p, __ATOMIC_RELAXED, __HIP_MEMORY_SCOPE_AGENT); }
__device__ __forceinline__ unsigned xb_add(unsigned* p, unsigned v) { return __hip_atomic_fetch_add(p, v, __ATOMIC_RELAXED, __HIP_MEMORY_SCOPE_AGENT); }
__device__ __forceinline__ unsigned xb_xcc_id() { return (unsigned)__builtin_amdgcn_s_getreg((3 << 11) | 20) & 0xFu; }
#define XB_SPIN(cond, bar) do { unsigned _sp = 0; while (cond) { __builtin_amdgcn_s_sleep(1); \
    if ((++_sp & 255u) == 0u) { if (xb_ld(&(bar)[XB_TMO])) break; if (_sp > XB_SPIN_CAP) { atomicAdd(&(bar)[XB_TMO], 1u); break; } } } } while (0)
struct XcdBarrier { unsigned* bar; unsigned x; volatile LAS unsigned* st; };
__device__ __forceinline__ XcdBarrier xcd_barrier_post(unsigned* bar, volatile LAS unsigned* st, bool t0) {
    XcdBarrier b; b.bar = bar; b.x = xb_xcc_id(); b.st = st;
    if (t0) (void)xb_add(&bar[XB_XCNT(b.x)], 1u);
    return b;
}
__device__ __forceinline__ void xcd_barrier_complete(unsigned* bar, unsigned x, unsigned& nloc, unsigned& nx) {
    const unsigned G = gridDim.x * gridDim.y * gridDim.z;
    unsigned sum, cnt, mine, sp = 0u;
    for (;;) {
        sum = 0u; cnt = 0u; mine = 0u;
#pragma unroll
        for (unsigned j = 0; j < 16; ++j) { const unsigned c = xb_ld(&bar[XB_XCNT(j)]); sum += c; cnt += (c > 0u) ? 1u : 0u; mine = (j == x) ? c : mine; }
        if (sum == G) break;
        __builtin_amdgcn_s_sleep(1);
        if ((++sp & 255u) == 0u) { if (xb_ld(&bar[XB_TMO])) break; if (sp > XB_SPIN_CAP) { atomicAdd(&bar[XB_TMO], 1u); break; } }
    }
    nloc = mine > 0u ? mine : 1u; nx = cnt > 0u ? cnt : 1u;
}
__device__ __forceinline__ void xcd_barrier(const XcdBarrier& b, bool t0) {
    asm volatile("s_waitcnt vmcnt(0)" ::: "memory");
    __syncthreads();
    if (t0) {
        unsigned* bar = b.bar;
        __builtin_amdgcn_s_waitcnt(0);
        unsigned nloc = b.st[0], nx = b.st[1];
        if (nloc == 0u) { xcd_barrier_complete(bar, b.x, nloc, nx); b.st[0] = nloc; b.st[1] = nx; }
        const unsigned old = xb_add(&bar[XB_XSUB(b.x)], 1u);
        const unsigned gen = old / nloc;
        if (old + 1u == (gen + 1u) * nloc) {
            __builtin_amdgcn_fence(__ATOMIC_RELEASE, "agent");
            asm volatile("s_waitcnt vmcnt(0)" ::: "memory");
            const unsigned og = xb_add(&bar[XB_TOP], 1u);
            const unsigned tg = og / nx;
            if (og + 1u == (tg + 1u) * nx) xb_add(&bar[XB_TOPGEN], 1u);
            else XB_SPIN(xb_ld(&bar[XB_TOPGEN]) == tg, bar);
            __builtin_amdgcn_fence(__ATOMIC_ACQUIRE, "agent");
            xb_add(&bar[XB_XGEN(b.x)], 1u);
            asm volatile("s_waitcnt vmcnt(0)" ::: "memory");
        } else {
            XB_SPIN(xb_ld(&bar[XB_XGEN(b.x)]) == gen, bar);
            __builtin_amdgcn_fence(__ATOMIC_ACQUIRE, "agent");
            asm volatile("s_waitcnt vmcnt(0)" ::: "memory");
        }
    }
    __syncthreads();
}

typedef const __attribute__((address_space(4))) Args* ArgsCP;
__device__ __forceinline__ Args load_args(ArgsCP p) { asm volatile("" : "+s"(p)); Args a;
#pragma unroll
    for (int i = 0; i < 16; ++i) a.in[i] = p->in[i];
    a.out = p->out; a.ws = p->ws; return a; }
__global__ void __launch_bounds__(NTHR, 2) fwd_kernel(Args a_unused) {
    extern __shared__ __attribute__((aligned(16))) unsigned char lds_raw[];
    LAS unsigned char* lds = (LAS unsigned char*)lds_raw;
    cg::grid_group grid = cg::this_grid();
    const int G = NWG, bid = blockIdx.x;
    const int wv = __builtin_amdgcn_readfirstlane(threadIdx.x >> 6);
    ArgsCP ap = (ArgsCP)__builtin_amdgcn_kernarg_segment_ptr();
#define GSYNC() do { XcdBarrier xb_; xb_.bar = (unsigned*)load_args(ap).ws; xb_.x = xb_xcc_id(); xb_.st = (volatile LAS unsigned*)(lds + LDS_BYTES - 16); xcd_barrier(xb_, opaque_tid(wv) == 0); } while (0)
#ifndef PH_MASK
#define PH_MASK 0xffff
#endif
#define PH(b) if constexpr ((PH_MASK >> (b)) & 1)
#ifndef DUP_MASK
#define DUP_MASK 0
#endif
#define REP(b) for (int rep_ = ((DUP_MASK >> (b)) & 1) ? 0 : 1; rep_ < 2; ++rep_)
#define DMY (rep_ == 0)
#define LOADARGS const Args a = load_args(ap); unsigned char* ws = a.ws; float* ssq = (float*)(ws + WS_SSQ); bf16_t* XB = (bf16_t*)(ws + WS_XB); bf16_t* HID = (bf16_t*)(ws + WS_HID); \
    const float* ssq0 = ssq + (size_t)(3 * l) * MTOK; float* ssq1 = ssq + (size_t)(3 * l + 1) * MTOK; float* ssq2 = ssq + (size_t)(3 * l + 2) * MTOK; float* ssq3 = ssq + (size_t)(3 * l + 3) * MTOK; \
    (void)ssq0; (void)ssq1; (void)ssq2; (void)ssq3; (void)XB; (void)HID;

    volatile LAS unsigned* xst = (volatile LAS unsigned*)(lds + LDS_BYTES - 16);
    { const int t_ = opaque_tid(wv); if (t_ < 4) xst[t_] = 0u; }
    if (load_args(ap).ws == nullptr) grid.sync();
    (void)xcd_barrier_post((unsigned*)load_args(ap).ws, xst, opaque_tid(wv) == 0);
    PH(0) { const int l = 0; LOADARGS; prologue_x(wv, a); }
    for (int l = 0; l < 2; ++l) {
        PH(1) REP(1) { LOADARGS; convert_weights(wv, a, l, lds);
            float* hs = (float*)(ws + WS_HSSQ);
            for (int i = bid * NTHR + opaque_tid(wv); i < MTOK * 24; i += NWG * NTHR) hs[i] = 0.f; }
        GSYNC();
        PH(2) REP(2) { LOADARGS; pg8::Gemm g{XB, (const bf16_t*)(ws + W_1T), MTOK, 2 * DFF, DM}; pg8::StaticOrder S; S.init(MTOK, 2 * DFF, G, bid); EpiFfnIn E{HID, ssq0}; pg8::gemm_phase(wv, lds, g, S, E); }
        GSYNC();
        PH(3) REP(3) { LOADARGS; pg8::Gemm g{HID, (const bf16_t*)(ws + W_1O), MTOK, DM, DFF}; pg8::StaticOrder S; S.init(MTOK, DM, G, bid); EpiResid E{a.out, XB, (unsigned char*)(ws + WS_XL), DMY ? (float*)(ws + WS_DUMMY) : ssq1, DMY ? 0.f : 0.5f, false}; pg8::gemm_phase(wv, lds, g, S, E); }
        GSYNC();
        PH(4) REP(4) { LOADARGS; pg8::Gemm g{XB, (const bf16_t*)(ws + W_IN), MTOK, 4096, DM}; pg8::StaticOrder S; S.init(MTOK, 4096, G, bid); EpiProjA E{(bf16_t*)(ws + WS_HQ), ssq1}; pg8::gemm_phase(wv, lds, g, S, E); }
        GSYNC();
        PH(5) REP(5) { LOADARGS; hgrn_pass<false>(wv, a, l, lds, bid, false); }
        GSYNC();
        PH(6) REP(6) { LOADARGS; hgrn_pass<true>(wv, a, l, lds, bid, DMY); }
        GSYNC();
        PH(7) REP(7) { LOADARGS; pg8::Gemm g{XB, (const bf16_t*)(ws + W_IN) + (size_t)4096 * DM, MTOK, 3 * ATW, DM}; pg8::StaticOrder S; S.init(MTOK, 3 * ATW, G, bid);
          EpiProjB E{(bf16_t*)(ws + WS_AQ), ssq1, (float*)(ws + (DMY ? WS_DUMMY : WS_HSSQ)), a.in[8] + l * 384, a.in[9] + l * 384, (const float*)(ws + WS_COS), (const float*)(ws + WS_SIN)}; pg8::gemm_phase(wv, lds, g, S, E); }
        GSYNC();
        PH(8) REP(8) { LOADARGS; attn_phase(wv, a, lds, bid, DMY); }
        GSYNC();
        PH(9) REP(9) { LOADARGS; attn_merge(wv, a); }
        GSYNC();
        PH(10) { pg8::StaticOrder S; S.init(MTOK, DM, G, bid);
          { LOADARGS; pg8::Gemm g{(const bf16_t*)a.out, (const bf16_t*)(ws + W_A), MTOK, DM, DM}; EpiStoreBf16 E{(bf16_t*)(ws + WS_T1)}; pg8::gemm_phase(wv, lds, g, S, E); }
          { LOADARGS; pg8::Gemm g{(const bf16_t*)(ws + WS_OB), (const bf16_t*)(ws + W_B), MTOK, DM, 512}; EpiStoreBf16 E{(bf16_t*)(ws + WS_T2)}; pg8::gemm_phase(wv, lds, g, S, E); }
          { LOADARGS; PairOrder S2; S2.S = S;
            pg8::Gemm g{XB, (const bf16_t*)(ws + W_IN) + (size_t)8704 * DM, MTOK, 2 * DM, DM}; EpiGateMerge E{(bf16_t*)(ws + WS_T1), (const bf16_t*)(ws + WS_T2), ssq1}; pg8::gemm_phase(wv, lds, g, S2, E); }
        }
        GSYNC();
        PH(11) REP(11) { LOADARGS; pg8::Gemm g{(const bf16_t*)(ws + WS_T1), (const bf16_t*)(ws + W_O), MTOK, DM, DM}; pg8::StaticOrder S; S.init(MTOK, DM, G, bid); EpiResid E{a.out, XB, (unsigned char*)(ws + WS_XL), DMY ? (float*)(ws + WS_DUMMY) : ssq2, DMY ? 0.f : 1.0f, false}; pg8::gemm_phase(wv, lds, g, S, E); }
        GSYNC();
        PH(12) REP(12) { LOADARGS; pg8::Gemm g{XB, (const bf16_t*)(ws + W_2T), MTOK, 2 * DFF, DM}; pg8::StaticOrder S; S.init(MTOK, 2 * DFF, G, bid); EpiFfnIn E{HID, ssq2}; pg8::gemm_phase(wv, lds, g, S, E); }
        GSYNC();
        PH(13) REP(13) { LOADARGS; pg8::Gemm g{HID, (const bf16_t*)(ws + W_2O), MTOK, DM, DFF}; pg8::StaticOrder S; S.init(MTOK, DM, G, bid); EpiResid E{a.out, XB, (unsigned char*)(ws + WS_XL), DMY ? (float*)(ws + WS_DUMMY) : ssq3, DMY ? 0.f : 0.5f, l == 1}; pg8::gemm_phase(wv, lds, g, S, E); }
        GSYNC();
    }
}

extern "C" void kernel_launch(void* const* d_in, const int* in_sizes, int n_in, void* d_out, int out_size, void* d_ws, size_t ws_size, hipStream_t stream) {
    static int grid = 0;
    if (grid == 0) {
        int dev = 0, cus = 0, per_cu = 0;
        (void)hipGetDevice(&dev);
        (void)hipDeviceGetAttribute(&cus, hipDeviceAttributeMultiprocessorCount, dev);
        (void)hipFuncSetAttribute((const void*)fwd_kernel, hipFuncAttributeMaxDynamicSharedMemorySize, LDS_BYTES);
        (void)hipOccupancyMaxActiveBlocksPerMultiprocessor(&per_cu, (const void*)fwd_kernel, NTHR, LDS_BYTES);
        if (cus != NWG || per_cu < 1 || n_in != 16 || ws_size < 512 * MiB) fprintf(stderr, "kernel_launch: unexpected config cus %d per_cu %d n_in %d ws %zu\n", cus, per_cu, n_in, ws_size);
        grid = NWG;
    }
    Args a{};
    for (int i = 0; i < 16; ++i) a.in[i] = (const float*)d_in[i];
    a.out = (float*)d_out; a.ws = (unsigned char*)d_ws;
    if (hipMemsetAsync(d_ws, 0, 16384, stream) != hipSuccess) fprintf(stderr, "kernel_launch: memset of the barrier words failed\n");
    void* args[] = {&a};
    hipError_t e = hipLaunchCooperativeKernel((const void*)fwd_kernel, dim3(grid), dim3(NTHR), args, LDS_BYTES, stream);
    if (e != hipSuccess) fprintf(stderr, "cooperative launch failed: %s\n", hipGetErrorString(e));
}
```
